# Optimizing an MI355X kernel written in HIP

```python
import math
import jax, jax.numpy as jnp
from jax import lax
import numpy as np

D_MODEL = 1024
BATCH = 16
SEQ = 2048
DEPTH = 1

CHUNK = 64
D_MIX = D_MODEL
PLE_DIM = 256
D_FF = 2816
HG_WIDTH = D_MIX // 2
HG_HEADS = 4
HG_DK = 128
HG_DV = HG_WIDTH // HG_HEADS
HG_FDIM = HG_HEADS * HG_DK
SSD_WIDTH = D_MIX - HG_WIDTH
SSD_HEADDIM = 64
SSD_HEADS = SSD_WIDTH // SSD_HEADDIM
SSD_GROUPS = 2
SSD_HPG = SSD_HEADS // SSD_GROUPS
SSD_STATE = 128
SSD_CONV = 4
SSD_CONV_CH = SSD_WIDTH + 2 * SSD_GROUPS * SSD_STATE
MIX_COLS = (HG_FDIM, HG_FDIM, HG_WIDTH, HG_WIDTH, SSD_WIDTH, SSD_CONV_CH, SSD_HEADS)
MIX_SPLITS = tuple(int(c) for c in np.cumsum(MIX_COLS)[:-1])
MIX_TOTAL = sum(MIX_COLS)
DEEPNORM_ALPHA = (2.0 * DEPTH) ** 0.25
DEEPNORM_BETA = (8.0 * DEPTH) ** -0.25
LN_EPS = 1e-5
RMS_EPS = 1e-6

kernel_name = "hybrid_hgrn2_ssd_macaron_deepnorm_block"


def layer_norm(x, g, b):
    xf = x.astype(jnp.float32)
    mu = jnp.mean(xf, axis=-1, keepdims=True)
    var = jnp.mean(jnp.square(xf - mu), axis=-1, keepdims=True)
    return ((xf - mu) * lax.rsqrt(var + LN_EPS) * g + b).astype(x.dtype)


def rms_norm(x, g):
    xf = x.astype(jnp.float32)
    return xf * lax.rsqrt(jnp.mean(jnp.square(xf), axis=-1, keepdims=True) + RMS_EPS) * g


def swiglu(x, w_in, w_out):
    gate, up = jnp.split(x @ w_in, 2, axis=-1)
    return (jax.nn.silu(gate) * up) @ w_out


def hgrn2_mixer(q, f_raw, v, g, lb, norm_g):
    bsz, seqlen, _ = q.shape
    nc = seqlen // CHUNK
    f32 = jnp.float32
    f = lb + (1.0 - lb) * jax.nn.sigmoid(f_raw.astype(f32))
    log_f = jnp.log(f)
    k = 1.0 - f
    q = jax.nn.silu(q.astype(f32))
    v = v.astype(f32)

    def heads(t, d):
        return t.reshape(bsz, nc, CHUNK, HG_HEADS, d).transpose(1, 0, 3, 2, 4)

    qc, kc, vc = heads(q, HG_DK), heads(k, HG_DK), heads(v, HG_DV)
    bc = jnp.cumsum(heads(log_f, HG_DK), axis=3)
    causal = jnp.tril(jnp.ones((CHUNK, CHUNK), bool))

    def step(state, blk):
        qb, kb, vb, bb = blk
        diff = bb[:, :, :, None, :] - bb[:, :, None, :, :]
        decay = jnp.exp(jnp.where(causal[:, :, None], diff, -jnp.inf))
        scores = jnp.einsum('bhtk,bhtsk,bhsk->bhts', qb, decay, kb)
        o = scores @ vb + jnp.einsum('bhtk,bhkv->bhtv', qb * jnp.exp(bb), state)
        b_last = bb[:, :, -1:, :]
        state = (jnp.exp(b_last[:, :, 0, :, None]) * state
                 + jnp.einsum('bhsk,bhsv->bhkv', kb * jnp.exp(b_last - bb), vb))
        return state, o

    s0 = jnp.zeros((bsz, HG_HEADS, HG_DK, HG_DV), f32)
    _, o = lax.scan(step, s0, (qc, kc, vc, bc))
    o = o.transpose(1, 0, 3, 2, 4).reshape(bsz, seqlen, HG_HEADS, HG_DV)
    o = rms_norm(o, norm_g).reshape(bsz, seqlen, HG_WIDTH)
    return o * jax.nn.silu(g.astype(f32))


def ssd_mixer(z, xbc, dt_raw, conv_w, conv_b, dt_bias, a_log, d_skip, norm_g):
    bsz, seqlen, _ = xbc.shape
    nc = seqlen // CHUNK
    f32 = jnp.float32
    xpad = jnp.pad(xbc.astype(f32), ((0, 0), (SSD_CONV - 1, 0), (0, 0)))
    conv = conv_b + sum(conv_w[j] * xpad[:, j:j + seqlen] for j in range(SSD_CONV))
    xbc = jax.nn.silu(conv)
    xs, bm, cm = jnp.split(xbc, (SSD_WIDTH, SSD_WIDTH + SSD_GROUPS * SSD_STATE), axis=-1)
    xs = xs.reshape(bsz, nc, CHUNK, SSD_GROUPS, SSD_HPG, SSD_HEADDIM)
    bm = bm.reshape(bsz, nc, CHUNK, SSD_GROUPS, SSD_STATE)
    cm = cm.reshape(bsz, nc, CHUNK, SSD_GROUPS, SSD_STATE)
    dt = jax.nn.softplus(dt_raw.astype(f32) + dt_bias).reshape(bsz, nc, CHUNK, SSD_GROUPS, SSD_HPG)
    a = dt * (-jnp.exp(a_log.astype(f32))).reshape(SSD_GROUPS, SSD_HPG)
    a_cum = jnp.cumsum(a.transpose(0, 3, 4, 1, 2), axis=-1)
    causal = jnp.tril(jnp.ones((CHUNK, CHUNK), bool))
    seg = a_cum[..., :, None] - a_cum[..., None, :]
    lmat = jnp.exp(jnp.where(causal, seg, -jnp.inf))
    dtx = xs * dt[..., None]
    cb = jnp.einsum('bctgn,bcsgn->bgcts', cm, bm)
    y_diag = jnp.einsum('bgcts,bgrcts,bcsgrp->bctgrp', cb, lmat, dtx)
    decay_end = jnp.exp(a_cum[..., -1:] - a_cum)
    states = jnp.einsum('bcsgn,bgrcs,bcsgrp->cbgrpn', bm, decay_end, dtx)
    chunk_decay = jnp.moveaxis(jnp.exp(a_cum[..., -1]), -1, 0)

    def pass_state(h, inp):
        dec, st = inp
        return dec[..., None, None] * h + st, h

    h0 = jnp.zeros((bsz, SSD_GROUPS, SSD_HPG, SSD_HEADDIM, SSD_STATE), f32)
    _, h_prev = lax.scan(pass_state, h0, (chunk_decay, states))
    y_off = jnp.einsum('bctgn,bgrct,cbgrpn->bctgrp', cm, jnp.exp(a_cum), h_prev)
    y = y_diag + y_off + d_skip.astype(f32).reshape(SSD_GROUPS, SSD_HPG, 1) * xs
    y = y.reshape(bsz, seqlen, SSD_WIDTH)
    return rms_norm(y * jax.nn.silu(z.astype(f32)), norm_g)


def setup_inputs(seed: int = 0) -> dict:
    key = jax.random.key(seed)
    ks = jax.random.split(key, 32)
    f32 = jnp.float32

    def nrm(k, shape, scale):
        return scale * jax.random.normal(k, shape, f32)

    def gain(k, shape):
        return 1.0 + nrm(k, shape, 0.02)

    dt = jnp.exp(jax.random.uniform(ks[13], (DEPTH, SSD_HEADS), f32, math.log(1e-3), math.log(1e-1)))
    return {
        "x": nrm(ks[0], (BATCH, SEQ, D_MODEL), 1.0),
        "p": nrm(ks[1], (DEPTH, BATCH, SEQ, PLE_DIM), 1.0),
        "ffn1_w_in": nrm(ks[2], (DEPTH, D_MODEL, 2 * D_FF), D_MODEL ** -0.5),
        "ffn1_w_out": nrm(ks[3], (DEPTH, D_FF, D_MODEL), DEEPNORM_BETA * D_FF ** -0.5),
        "ln1_g": gain(ks[4], (DEPTH, D_MODEL)),
        "ln1_b": nrm(ks[5], (DEPTH, D_MODEL), 0.02),
        "w_in_mix": nrm(ks[6], (DEPTH, D_MODEL, MIX_TOTAL), D_MODEL ** -0.5),
        "hgrn_lb_logits": nrm(ks[7], (DEPTH + 1, HG_FDIM), 0.1),
        "hgrn_norm_g": gain(ks[8], (DEPTH, HG_DV)),
        "ssd_conv_w": nrm(ks[9], (DEPTH, SSD_CONV, SSD_CONV_CH), SSD_CONV ** -0.5),
        "ssd_conv_b": nrm(ks[10], (DEPTH, SSD_CONV_CH), 0.02),
        "ssd_dt_bias": dt + jnp.log(-jnp.expm1(-dt)),
        "ssd_a_log": jnp.log(jax.random.uniform(ks[11], (DEPTH, SSD_HEADS), f32, 1.0, 16.0)),
        "ssd_d": gain(ks[12], (DEPTH, SSD_HEADS)),
        "ssd_norm_g": gain(ks[14], (DEPTH, SSD_WIDTH)),
        "w_out_mix": nrm(ks[15], (DEPTH, D_MIX, D_MODEL), DEEPNORM_BETA * D_MIX ** -0.5),
        "ln2_g": gain(ks[16], (DEPTH, D_MODEL)),
        "ln2_b": nrm(ks[17], (DEPTH, D_MODEL), 0.02),
        "ffn2_w_in": nrm(ks[18], (DEPTH, D_MODEL, 2 * D_FF), D_MODEL ** -0.5),
        "ffn2_w_out": nrm(ks[19], (DEPTH, D_FF, D_MODEL), DEEPNORM_BETA * D_FF ** -0.5),
        "ln3_g": gain(ks[20], (DEPTH, D_MODEL)),
        "ln3_b": nrm(ks[21], (DEPTH, D_MODEL), 0.02),
        "ple_w_proj": nrm(ks[22], (DEPTH, PLE_DIM, D_MODEL), DEEPNORM_BETA * PLE_DIM ** -0.5),
        "ple_w_gate": nrm(ks[23], (DEPTH, D_MODEL, D_MODEL), D_MODEL ** -0.5),
        "ln4_g": gain(ks[24], (DEPTH, D_MODEL)),
        "ln4_b": nrm(ks[25], (DEPTH, D_MODEL), 0.02),
    }


def reference(x, p, ffn1_w_in, ffn1_w_out, ln1_g, ln1_b, w_in_mix, hgrn_lb_logits, hgrn_norm_g,
              ssd_conv_w, ssd_conv_b, ssd_dt_bias, ssd_a_log, ssd_d, ssd_norm_g, w_out_mix,
              ln2_g, ln2_b, ffn2_w_in, ffn2_w_out, ln3_g, ln3_b, ple_w_proj, ple_w_gate,
              ln4_g, ln4_b):
    lb_all = jnp.cumsum(jax.nn.softmax(hgrn_lb_logits.astype(jnp.float32), axis=0), axis=0)
    for i in range(DEPTH):
        x = layer_norm(DEEPNORM_ALPHA * x + 0.5 * swiglu(x, ffn1_w_in[i], ffn1_w_out[i]), ln1_g[i], ln1_b[i])
        hq, hf, hi, hg, sz, sxbc, sdt = jnp.split(x @ w_in_mix[i], MIX_SPLITS, axis=-1)
        o_hgrn = hgrn2_mixer(hq, hf, hi, hg, lb_all[i], hgrn_norm_g[i])
        o_ssd = ssd_mixer(sz, sxbc, sdt, ssd_conv_w[i], ssd_conv_b[i], ssd_dt_bias[i],
                          ssd_a_log[i], ssd_d[i], ssd_norm_g[i])
        mix = jnp.concatenate([o_hgrn, o_ssd], axis=-1) @ w_out_mix[i]
        x = layer_norm(DEEPNORM_ALPHA * x + mix, ln2_g[i], ln2_b[i])
        x = layer_norm(DEEPNORM_ALPHA * x + 0.5 * swiglu(x, ffn2_w_in[i], ffn2_w_out[i]), ln3_g[i], ln3_b[i])
        ple = jax.nn.sigmoid(x @ ple_w_gate[i]) * (p[i] @ ple_w_proj[i])
        x = layer_norm(DEEPNORM_ALPHA * x + ple, ln4_g[i], ln4_b[i])
    return x
```

```cpp
#include <hip/hip_runtime.h>
#include <cstdio>
#include <cstdint>
namespace pg8 {
#define PG8_LAS __attribute__((address_space(3)))
typedef unsigned short bf16_t;
typedef short bf16x8 __attribute__((ext_vector_type(8)));
typedef float f32x4 __attribute__((ext_vector_type(4)));
typedef unsigned u32x4 __attribute__((ext_vector_type(4)));
constexpr int BM = 256, BK = 64, HALF = 128, HTB = HALF * BK * 2  , STAGE_BYTES = 8 * HTB, NXCD = 8, WGM = 8;

__host__ __device__ __forceinline__ int lds_byte(int r, int c) { const int st = (r >> 4) * 2 + (c >> 5), rr = r & 15, cc = c & 31, ob = rr * 64 + cc * 2; return st * 1024 + (ob ^ (((ob >> 9) & 1) << 5)); }
__host__ __device__ __forceinline__ void stage_rc(int b, int& R, int& C) { const int st = b / 1024, sb = b % 1024, swz = sb ^ (((sb >> 9) & 1) << 5); R = (st >> 1) * 16 + swz / 64; C = (st & 1) * 32 + (swz % 64) / 2; }
__host__ __device__ __forceinline__ int perm32(int rho) { const int n = rho >> 4, i = rho & 15; return 8 * (i >> 2) + 4 * n + (i & 3); }

struct Unit { int pm, pn; };
struct Gemm { const bf16_t* A; const bf16_t* Bt; int M, N, K; };

struct StaticOrder {
    int nM, nN, nwg, G, c;
    __host__ __device__ void init(int M, int N, int G_, int c_) { nM = M / BM; nN = N / BM; nwg = nM * nN; G = G_; c = c_; }
    __host__ __device__ bool next(int i, Unit& u) const {
        const long L = (long)i * G + c; if (L >= nwg) return false;
        int wgid = (int)L; { const int q = nwg / NXCD, r = nwg % NXCD, xcd = wgid % NXCD, off = wgid / NXCD; wgid = (xcd < r ? xcd * (q + 1) : r * (q + 1) + (xcd - r) * q) + off; }
        const int nig = WGM * nN, gid = wgid / nig, fm = gid * WGM, gsz = (nM - fm) < WGM ? (nM - fm) : WGM;
        u.pm = fm + ((wgid % nig) % gsz); u.pn = (wgid % nig) / gsz; return true;
    }
    __device__ __forceinline__ void a_ready(const Unit&) const {}
    __device__ __forceinline__ void done(const Unit&) const {}
};

__device__ __forceinline__ unsigned cvt_pk_bf16(float lo, float hi) { unsigned r; asm volatile("v_cvt_pk_bf16_f32 %0, %1, %2" : "=v"(r) : "v"(lo), "v"(hi)); return r; }
typedef float f32x2 __attribute__((ext_vector_type(2)));
__device__ __forceinline__ f32x2 gelu_pk(f32x2 v) {
    const f32x2 av = __builtin_elementwise_abs(v), d = av * 0.2316418882f + 1.0f;
    f32x2 t; t.x = __builtin_amdgcn_rcpf(d.x); t.y = __builtin_amdgcn_rcpf(d.y);
    f32x2 q = t * 0.5307027145f + (-0.7265760135f); q = q * t + 0.7107068705f; q = q * t + (-0.142248368f); q = q * t + 0.127414796f; q = q * t;
    const f32x2 s = (v * v) * (-0.72134752044f);
    f32x2 e; e.x = __builtin_amdgcn_exp2f(s.x); e.y = __builtin_amdgcn_exp2f(s.y);
    const f32x2 m = v * (q * e), r = v - m;
    f32x2 o; o.x = v.x < 0.f ? m.x : r.x; o.y = v.y < 0.f ? m.y : r.y; return o;
}

template <int ACT  > struct EpiBf16 {
    static constexpr bool PERM = true, AFTER_DRAIN = false; static_assert(ACT == 0 || ACT == 1, "EpiBf16: ACT is 0 (none) or 1 (gelu_pk)");
    bf16_t* O; int ldc; const float* bias; int split_cols; size_t split_stride; float scale0;
    __device__ __forceinline__ void operator()(const f32x4 (&acc)[2][2][4][2], const Unit& u, int wr, int wc, int fr, int fq) const {
        const int row0 = u.pm * BM + wr * 64 + fr; int colt = u.pn * BM; bf16_t* base = O;
        float sc = 1.f; if (split_cols) { const int t = colt / split_cols; base += (size_t)t * split_stride; colt -= t * split_cols; if (t == 0) sc = scale0; }
        const int col0 = colt + wc * 32 + 8 * fq, bcol0 = u.pn * BM + wc * 32 + 8 * fq;
        f32x4 bv[2][2];
#pragma unroll
        for (int bj = 0; bj < 2; ++bj)
#pragma unroll
            for (int n = 0; n < 2; ++n) bv[bj][n] = bias ? *(const f32x4*)(bias + bcol0 + bj * HALF + 4 * n) : (f32x4){0.f, 0.f, 0.f, 0.f};
#pragma unroll
        for (int ai = 0; ai < 2; ++ai)
#pragma unroll
            for (int m = 0; m < 4; ++m) { bf16_t* rowp = base + (size_t)(row0 + ai * HALF + m * 16) * ldc + col0;
#pragma unroll
                for (int bj = 0; bj < 2; ++bj) { f32x4 v0 = acc[ai][bj][m][0] + bv[bj][0], v1 = acc[ai][bj][m][1] + bv[bj][1];
                    if (ACT == 1) { f32x2 a = gelu_pk((f32x2){v0[0], v0[1]}), b = gelu_pk((f32x2){v0[2], v0[3]}), c = gelu_pk((f32x2){v1[0], v1[1]}), d = gelu_pk((f32x2){v1[2], v1[3]});
                        v0 = (f32x4){a.x, a.y, b.x, b.y}; v1 = (f32x4){c.x, c.y, d.x, d.y}; }
                    v0 = v0 * sc; v1 = v1 * sc; u32x4 w; w.x = cvt_pk_bf16(v0[0], v0[1]); w.y = cvt_pk_bf16(v0[2], v0[3]); w.z = cvt_pk_bf16(v1[0], v1[1]); w.w = cvt_pk_bf16(v1[2], v1[3]);
                    *(u32x4*)(rowp + bj * HALF) = w; } }
    }
};

struct PanelStats {
    unsigned* xbuf;
    unsigned* cnt;
    unsigned* tmo;
    int ntn; float eps;
    unsigned code;
    __device__ __forceinline__ bool run(const f32x4 (&v)[2][2][4][2], const Unit& u, int wr, int wc, int fr, int fq, PG8_LAS unsigned char* lds, int wid, int lane) const {
        typedef float f32x2v __attribute__((ext_vector_type(2)));
        PG8_LAS f32x2v* P = (PG8_LAS f32x2v*)lds;
        PG8_LAS f32x2v* S = (PG8_LAS f32x2v*)(lds + 8192);
        PG8_LAS unsigned* flag = (PG8_LAS unsigned*)(lds + 8192 + 2048);
#pragma unroll
        for (int ai = 0; ai < 2; ++ai)
#pragma unroll
            for (int m = 0; m < 4; ++m) {
                float s = 0.f;
#pragma unroll
                for (int bj = 0; bj < 2; ++bj)
#pragma unroll
                    for (int n = 0; n < 2; ++n) { const f32x4 x = v[ai][bj][m][n]; s += (x[0] + x[1]) + (x[2] + x[3]); }
                s += __shfl_xor(s, 16); s += __shfl_xor(s, 32);
                const float mw = s * (1.0f / 64.0f); float q = 0.f;
#pragma unroll
                for (int bj = 0; bj < 2; ++bj)
#pragma unroll
                    for (int n = 0; n < 2; ++n) { const f32x4 d = v[ai][bj][m][n] - mw; q += (d[0] * d[0] + d[1] * d[1]) + (d[2] * d[2] + d[3] * d[3]); }
                q += __shfl_xor(q, 16); q += __shfl_xor(q, 32);
                if (fq == 0) P[(ai * HALF + wr * 64 + m * 16 + fr) * 4 + wc] = (f32x2v){mw, q};
            }
        asm volatile("s_waitcnt lgkmcnt(0)" ::: "memory"); __builtin_amdgcn_s_barrier(); asm volatile("" ::: "memory");
#if defined(BROKEN_EXCHANGE_NO_WAIT)
#warning BROKEN CONTROL BUILD: the row-statistics exchange does not wait; results are wrong by design
        if (blockIdx.x >= 64) { const long long t0_ = clock64(); while (clock64() - t0_ < 60000) __builtin_amdgcn_s_sleep(8); }
#endif
        const int row = wid * 32 + (lane & 31);
        if (lane < 32) {
            const f32x2v a = P[row * 4 + 0], b = P[row * 4 + 1], c = P[row * 4 + 2], d = P[row * 4 + 3];
            const float mt = (a.x + b.x + c.x + d.x) * 0.25f;
            const float da = a.x - mt, db = b.x - mt, dc = c.x - mt, dd = d.x - mt;
            const float m2 = (a.y + b.y) + (c.y + d.y) + 64.0f * ((da * da + db * db) + (dc * dc + dd * dd));
            unsigned long long* slot = (unsigned long long*)xbuf + ((size_t)(u.pm * BM + row) * 4 + u.pn);
            __hip_atomic_store(slot, ((unsigned long long)__float_as_uint(m2) << 32) | __float_as_uint(mt), __ATOMIC_RELAXED, __HIP_MEMORY_SCOPE_AGENT);
        }
        asm volatile("s_waitcnt vmcnt(0)" ::: "memory");
        if (lane == 0) __hip_atomic_fetch_add(cnt + 64 * u.pm, 1u, __ATOMIC_RELAXED, __HIP_MEMORY_SCOPE_AGENT);
        if (wid == 0) {
            bool dead = false; const unsigned long long t0 = __builtin_amdgcn_s_memrealtime(); const unsigned want = 8u * (unsigned)ntn;
            for (;;) {
#if defined(BROKEN_EXCHANGE_NO_WAIT)
                break;
#endif
                if ((unsigned)__builtin_amdgcn_readfirstlane(__hip_atomic_load(cnt + 64 * u.pm, __ATOMIC_RELAXED, __HIP_MEMORY_SCOPE_AGENT)) >= want) break;
                if (__builtin_amdgcn_s_memrealtime() - t0 > 2000000ull) {
                    if (lane == 0) { unsigned expect = 0u; __hip_atomic_compare_exchange_strong(tmo + 1, &expect, code | (unsigned)(u.pm & 0xff), __ATOMIC_RELAXED, __ATOMIC_RELAXED, __HIP_MEMORY_SCOPE_AGENT);
                                     __hip_atomic_store(tmo, 1u, __ATOMIC_RELAXED, __HIP_MEMORY_SCOPE_AGENT); }
                    dead = true; break; }
                __builtin_amdgcn_s_sleep(2);
            }
            __builtin_amdgcn_fence(__ATOMIC_ACQUIRE, "agent");
            if (lane == 0) flag[0] = dead ? 1u : 0u;
        }
        asm volatile("s_waitcnt vmcnt(0) lgkmcnt(0)" ::: "memory"); __builtin_amdgcn_s_barrier(); asm volatile("" ::: "memory");
        const bool bad = flag[0] != 0u;
        if (lane < 32) {
            const unsigned long long* slot = (const unsigned long long*)xbuf + (size_t)(u.pm * BM + row) * 4; float mt[4], m2[4]; float ms = 0.f;
#pragma unroll
            for (int t = 0; t < 4; ++t) { if (t < ntn) { const unsigned long long w = __hip_atomic_load(slot + t, __ATOMIC_RELAXED, __HIP_MEMORY_SCOPE_AGENT); mt[t] = __uint_as_float((unsigned)w); m2[t] = __uint_as_float((unsigned)(w >> 32)); } else { mt[t] = 0.f; m2[t] = 0.f; } ms += mt[t]; }
            const float mean = ms / (float)ntn; float q = 0.f;
#pragma unroll
            for (int t = 0; t < 4; ++t) if (t < ntn) { const float dm = mt[t] - mean; q += m2[t] + 256.0f * dm * dm; }
            S[row] = (f32x2v){mean, 1.0f / sqrtf(q / (256.0f * (float)ntn) + eps)};
        }
        asm volatile("s_waitcnt lgkmcnt(0)" ::: "memory"); __builtin_amdgcn_s_barrier(); asm volatile("" ::: "memory");
        return bad;
    }
};
struct EpiLnRes {
    static constexpr bool PERM = false, AFTER_DRAIN = true;
    const float* base; float* out; int ldc; const float* bias; PanelStats st; unsigned poison;
    __device__ __forceinline__ void fused(f32x4 (&acc)[2][2][4][2], const Unit& u, int wr, int wc, int fr, int fq, PG8_LAS unsigned char* lds, int wid, int lane) const {
        typedef float f32x2v __attribute__((ext_vector_type(2)));
        const PG8_LAS f32x2v* S = (const PG8_LAS f32x2v*)(lds + 8192);
        const int col0 = u.pn * BM + wc * 32 + 4 * fq;
#pragma unroll
        for (int bj = 0; bj < 2; ++bj)
#pragma unroll
            for (int n = 0; n < 2; ++n) { const f32x4 bv = bias ? *(const f32x4*)(bias + col0 + bj * HALF + n * 16) : (f32x4){0.f, 0.f, 0.f, 0.f};
#pragma unroll
                for (int ai = 0; ai < 2; ++ai)
#pragma unroll
                    for (int m = 0; m < 4; ++m) acc[ai][bj][m][n] += bv; }
        f32x4 pre[4][2][2];
#pragma unroll
        for (int m = 0; m < 4; ++m) { const size_t off = (size_t)(u.pm * BM + wr * 64 + m * 16 + fr) * ldc + col0;
#pragma unroll
            for (int bj = 0; bj < 2; ++bj)
#pragma unroll
                for (int n = 0; n < 2; ++n) pre[m][bj][n] = *(const f32x4*)(base + off + bj * HALF + n * 16); }
        const bool bad = st.run(acc, u, wr, wc, fr, fq, lds, wid, lane) || poison != 0u;
        const float qnan = __builtin_nanf("");
#pragma unroll
        for (int ai = 0; ai < 2; ++ai)
#pragma unroll
            for (int m = 0; m < 4; ++m) { const int r = ai * HALF + wr * 64 + m * 16 + fr; const f32x2v sr = S[r]; const size_t off = (size_t)(u.pm * BM + r) * ldc + col0;
#pragma unroll
                for (int bj = 0; bj < 2; ++bj)
#pragma unroll
                    for (int n = 0; n < 2; ++n) { const f32x4 bs = ai == 0 ? pre[m][bj][n] : *(const f32x4*)(base + off + bj * HALF + n * 16); f32x4 o = bs + (acc[ai][bj][m][n] - sr.x) * sr.y;
                        if (bad) o = (f32x4){qnan, qnan, qnan, qnan}; *(f32x4*)(out + off + bj * HALF + n * 16) = o; }
                if (m & 1) asm volatile("" ::: "memory"); }
    }
};
struct EpiLnResLn {
    static constexpr bool PERM = false, AFTER_DRAIN = true;
    const float* base; float* out; bf16_t* xn; int ldc; const float* bias; PanelStats st1, st2; unsigned poison;
    __device__ __forceinline__ void fused(f32x4 (&acc)[2][2][4][2], const Unit& u, int wr, int wc, int fr, int fq, PG8_LAS unsigned char* lds, int wid, int lane) const {
        typedef float f32x2v __attribute__((ext_vector_type(2))); typedef unsigned u32x2v __attribute__((ext_vector_type(2)));
        const PG8_LAS f32x2v* S = (const PG8_LAS f32x2v*)(lds + 8192);
        const int col0 = u.pn * BM + wc * 32 + 4 * fq;
#pragma unroll
        for (int bj = 0; bj < 2; ++bj)
#pragma unroll
            for (int n = 0; n < 2; ++n) { const f32x4 bv = bias ? *(const f32x4*)(bias + col0 + bj * HALF + n * 16) : (f32x4){0.f, 0.f, 0.f, 0.f};
#pragma unroll
                for (int ai = 0; ai < 2; ++ai)
#pragma unroll
                    for (int m = 0; m < 4; ++m) acc[ai][bj][m][n] += bv; }
        bool bad = st1.run(acc, u, wr, wc, fr, fq, lds, wid, lane) || poison != 0u;
        const float qnan = __builtin_nanf("");
#pragma unroll
        for (int ai = 0; ai < 2; ++ai)
#pragma unroll
            for (int m = 0; m < 4; ++m) { const int r = ai * HALF + wr * 64 + m * 16 + fr; const f32x2v sr = S[r]; const size_t off = (size_t)(u.pm * BM + r) * ldc + col0;
#pragma unroll
                for (int bj = 0; bj < 2; ++bj)
#pragma unroll
                    for (int n = 0; n < 2; ++n) { const f32x4 bs = *(const f32x4*)(base + off + bj * HALF + n * 16); acc[ai][bj][m][n] = bs + (acc[ai][bj][m][n] - sr.x) * sr.y; }
                asm volatile("" : "+v"(acc[ai][0][m][0]), "+v"(acc[ai][0][m][1]), "+v"(acc[ai][1][m][0]), "+v"(acc[ai][1][m][1]));
                if (m & 1) asm volatile("" ::: "memory"); }
        const bool bad1 = bad;
        bad = st2.run(acc, u, wr, wc, fr, fq, lds, wid, lane) || bad;
#pragma unroll
        for (int ai = 0; ai < 2; ++ai)
#pragma unroll
            for (int m = 0; m < 4; ++m) { const int r = ai * HALF + wr * 64 + m * 16 + fr; const f32x2v sr = S[r]; const size_t off = (size_t)(u.pm * BM + r) * ldc + col0;
#pragma unroll
                for (int bj = 0; bj < 2; ++bj)
#pragma unroll
                    for (int n = 0; n < 2; ++n) { const f32x4 x1 = acc[ai][bj][m][n]; *(f32x4*)(out + off + bj * HALF + n * 16) = bad1 ? (f32x4){qnan, qnan, qnan, qnan} : x1;
                        const f32x4 o = (x1 - sr.x) * sr.y; u32x2v w; w.x = cvt_pk_bf16(o[0], o[1]); w.y = cvt_pk_bf16(o[2], o[3]);
                        if (bad) { w.x = 0x7fc07fc0u; w.y = 0x7fc07fc0u; } *(u32x2v*)(xn + off + bj * HALF + n * 16) = w; }
                asm volatile("" ::: "memory"); }
    }
};

template <class Epi, class Sched, bool ALIGN_EPI = false, bool SP2 = false>
__device__ __forceinline__ void gemm_phase(PG8_LAS unsigned char* lds, const Gemm g, const Sched& S, const Epi& E) {
    const int tid = threadIdx.x, wid = __builtin_amdgcn_readfirstlane(tid >> 6), lane = tid & 63, wr = wid >> 2, wc = wid & 3, fr = lane & 15, fq = lane >> 4;
    const int K = g.K, nt = K / BK;
    unsigned voffA[2], voffB[2];
#pragma unroll
    for (int i = 0; i < 2; ++i) { int R, C; stage_rc(tid * 16 + i * 8192, R, C); const int Rb = Epi::PERM ? ((R & ~31) + perm32(R & 31)) : R;
        voffA[i] = (unsigned)(R * K + C) * 2u; voffB[i] = (unsigned)(Rb * K + C) * 2u; }
    const size_t kstep = (size_t)(BK * 2);
    const size_t hstep = (size_t)HALF * K * 2;
    const size_t tstep = 2 * hstep;
    const unsigned ldsw = (unsigned)wid * 1024u;
    const int aoff = lds_byte(wr * 64 + fr, fq * 8), boff = lds_byte(wc * 32 + fr, fq * 8);
#define PG8_SA(b, h) (((b) * 2 + (h)) * HTB)
#define PG8_SB(b, h) ((4 + (b) * 2 + (h)) * HTB)
#define PG8_STAGE(bufoff, gbase, voff) do { _Pragma("unroll") for (int _i = 0; _i < 2; ++_i) \
        __builtin_amdgcn_global_load_lds((const unsigned*)((const char*)(gbase) + (voff)[_i]), (PG8_LAS unsigned*)(lds + (bufoff) + ldsw + _i * 8192), 16, 0, 0); } while (0)
#define PG8_LDA(dst, b, h) do { _Pragma("unroll") for (int m = 0; m < 4; ++m) _Pragma("unroll") for (int k = 0; k < 2; ++k) dst[m][k] = *(const PG8_LAS bf16x8*)(lds + PG8_SA(b, h) + aoff + m * 2048 + k * 1024); } while (0)
#define PG8_LDB(dst, b, h) do { _Pragma("unroll") for (int n = 0; n < 2; ++n) _Pragma("unroll") for (int k = 0; k < 2; ++k) dst[n][k] = *(const PG8_LAS bf16x8*)(lds + PG8_SB(b, h) + boff + n * 2048 + k * 1024); } while (0)
#define PG8_MMA(ai, bj, At, Bt) do { __builtin_amdgcn_s_setprio(1); _Pragma("unroll") for (int m = 0; m < 4; ++m) _Pragma("unroll") for (int n = 0; n < 2; ++n) _Pragma("unroll") for (int k = 0; k < 2; ++k) \
        acc[ai][bj][m][n] = __builtin_amdgcn_mfma_f32_16x16x32_bf16(Bt[n][k], At[m][k], acc[ai][bj][m][n], 0, 0, 0); __builtin_amdgcn_s_setprio(0); } while (0)
#define PG8_WAIT_V(n) asm volatile("s_waitcnt vmcnt(" #n ")" ::: "memory")
#define PG8_WAIT_L(n) asm volatile("s_waitcnt lgkmcnt(" #n ")" ::: "memory")
#define PG8_BAR __builtin_amdgcn_s_barrier()
#define PG8_SCHED __builtin_amdgcn_sched_barrier(0)
    Unit cur, nxt; int ui = 0;
    if (!S.next(0, cur)) return;
    f32x4 acc[2][2][4][2];
#pragma unroll
    for (int a = 0; a < 2; ++a)
#pragma unroll
        for (int b = 0; b < 2; ++b)
#pragma unroll
            for (int m = 0; m < 4; ++m)
#pragma unroll
                for (int n = 0; n < 2; ++n) acc[a][b][m][n] = (f32x4){0.f, 0.f, 0.f, 0.f};
    bf16x8 At[4][2], B0[2][2], B1[2][2];
    const char* cA = (const char*)g.A + (size_t)cur.pm * tstep; const char* cB = (const char*)g.Bt + (size_t)cur.pn * tstep;
    S.a_ready(cur);
    if constexpr (SP2) {
        PG8_STAGE(PG8_SB(0, 0), cB, voffB); PG8_STAGE(PG8_SB(0, 1), cB + hstep, voffB); PG8_STAGE(PG8_SA(0, 0), cA, voffA); PG8_STAGE(PG8_SA(0, 1), cA + hstep, voffA);
        if (wr == 1) PG8_BAR;
        PG8_WAIT_V(2); PG8_BAR;
        PG8_STAGE(PG8_SB(1, 0), cB + kstep, voffB); PG8_STAGE(PG8_SA(1, 0), cA + kstep, voffA); PG8_STAGE(PG8_SB(1, 1), cB + hstep + kstep, voffB);
        PG8_WAIT_V(6); PG8_BAR;
    } else {
        PG8_STAGE(PG8_SB(0, 0), cB, voffB); PG8_STAGE(PG8_SA(0, 0), cA, voffA); PG8_STAGE(PG8_SB(0, 1), cB + hstep, voffB); PG8_STAGE(PG8_SA(0, 1), cA + hstep, voffA);
        if (wr == 1) PG8_BAR;
        PG8_WAIT_V(4); PG8_BAR;
        PG8_STAGE(PG8_SB(1, 0), cB + kstep, voffB); PG8_STAGE(PG8_SA(1, 0), cA + kstep, voffA); PG8_STAGE(PG8_SB(1, 1), cB + hstep + kstep, voffB);
        PG8_WAIT_V(6); PG8_BAR;
    }
    for (;;) {
        const bool has_next = S.next(ui + 1, nxt);
        const char* nA = has_next ? (const char*)g.A + (size_t)nxt.pm * tstep : cA; const char* nB = has_next ? (const char*)g.Bt + (size_t)nxt.pn * tstep : cB;
        for (int t = 0; t < nt; t += 2) {
            const bool last = (t == nt - 2);
            const char* a1 = cA + (size_t)(t + 1) * kstep;
            const char* a2 = last ? nA : cA + (size_t)(t + 2) * kstep; const char* b2 = last ? nB : cB + (size_t)(t + 2) * kstep;
            const char* a3 = a2 + kstep; const char* b3 = b2 + kstep;
            if (last && has_next) S.a_ready(nxt);
            if constexpr (SP2) {
            PG8_LDB(B0, 0, 0); PG8_LDB(B1, 0, 1); PG8_SCHED; PG8_LDA(At, 0, 0); PG8_STAGE(PG8_SA(1, 1), a1 + hstep, voffA);
            PG8_WAIT_V(8); PG8_WAIT_L(0); PG8_BAR; PG8_MMA(0, 0, At, B0); PG8_MMA(0, 1, At, B1); PG8_BAR; PG8_SCHED;
            PG8_LDA(At, 0, 1); PG8_STAGE(PG8_SB(0, 0), b2, voffB); PG8_STAGE(PG8_SB(0, 1), b2 + hstep, voffB); PG8_STAGE(PG8_SA(0, 0), a2, voffA);
            PG8_WAIT_V(8); PG8_WAIT_L(0); PG8_BAR; PG8_MMA(1, 0, At, B0); PG8_MMA(1, 1, At, B1); PG8_BAR; PG8_SCHED;
            PG8_LDB(B0, 1, 0); PG8_LDB(B1, 1, 1); PG8_SCHED; PG8_LDA(At, 1, 0); PG8_STAGE(PG8_SA(0, 1), a2 + hstep, voffA);
            PG8_WAIT_V(8); PG8_WAIT_L(0); PG8_BAR; PG8_MMA(0, 0, At, B0); PG8_MMA(0, 1, At, B1); PG8_BAR; PG8_SCHED;
            PG8_LDA(At, 1, 1); PG8_STAGE(PG8_SB(1, 0), b3, voffB); PG8_STAGE(PG8_SB(1, 1), b3 + hstep, voffB); PG8_STAGE(PG8_SA(1, 0), a3, voffA);
            PG8_WAIT_V(8); PG8_WAIT_L(0); PG8_BAR; PG8_MMA(1, 0, At, B0); PG8_MMA(1, 1, At, B1); PG8_BAR; PG8_SCHED;
            } else {
            PG8_LDB(B0, 0, 0); PG8_SCHED; PG8_LDA(At, 0, 0); PG8_STAGE(PG8_SA(1, 1), a1 + hstep, voffA);
            PG8_WAIT_L(8); PG8_BAR; PG8_WAIT_L(0); PG8_MMA(0, 0, At, B0); PG8_BAR; PG8_SCHED;
            PG8_LDB(B1, 0, 1); PG8_STAGE(PG8_SB(0, 0), b2, voffB);
            PG8_BAR; PG8_WAIT_L(0); PG8_MMA(0, 1, At, B1); PG8_BAR;
            PG8_LDA(At, 0, 1); PG8_STAGE(PG8_SA(0, 0), a2, voffA);
            PG8_BAR; PG8_WAIT_L(0); PG8_MMA(1, 0, At, B0); PG8_BAR; PG8_SCHED;
            PG8_STAGE(PG8_SB(0, 1), b2 + hstep, voffB);
            PG8_WAIT_V(6); PG8_BAR; PG8_MMA(1, 1, At, B1); PG8_BAR;
            PG8_LDB(B0, 1, 0); PG8_SCHED; PG8_LDA(At, 1, 0); PG8_STAGE(PG8_SA(0, 1), a2 + hstep, voffA);
            PG8_WAIT_L(8); PG8_BAR; PG8_WAIT_L(0); PG8_MMA(0, 0, At, B0); PG8_BAR; PG8_SCHED;
            PG8_LDB(B1, 1, 1); PG8_STAGE(PG8_SB(1, 0), b3, voffB);
            PG8_BAR; PG8_WAIT_L(0); PG8_MMA(0, 1, At, B1); PG8_BAR;
            PG8_LDA(At, 1, 1); PG8_STAGE(PG8_SA(1, 0), a3, voffA);
            PG8_BAR; PG8_WAIT_L(0); PG8_MMA(1, 0, At, B0); PG8_BAR; PG8_SCHED;
            PG8_STAGE(PG8_SB(1, 1), b3 + hstep, voffB);
            PG8_WAIT_V(6); PG8_BAR; PG8_MMA(1, 1, At, B1); PG8_BAR;
            }
        }
        if constexpr (ALIGN_EPI) { if (wr == 0) PG8_BAR; }
        if constexpr (!Epi::AFTER_DRAIN) { E(acc, cur, wr, wc, fr, fq); S.done(cur); }
        if (!has_next) break;
#pragma unroll
        for (int a = 0; a < 2; ++a)
#pragma unroll
            for (int b = 0; b < 2; ++b)
#pragma unroll
                for (int m = 0; m < 4; ++m)
#pragma unroll
                    for (int n = 0; n < 2; ++n) acc[a][b][m][n] = (f32x4){0.f, 0.f, 0.f, 0.f};
        cur = nxt; cA = nA; cB = nB; ++ui;
        if constexpr (ALIGN_EPI) { if (wr == 1) PG8_BAR; }
    }
    PG8_WAIT_V(0);
    if constexpr (!ALIGN_EPI) { if (wr == 0) PG8_BAR; }
    PG8_BAR;
    if constexpr (Epi::AFTER_DRAIN) { E.fused(acc, cur, wr, wc, fr, fq, lds, wid, lane); S.done(cur); }
#undef PG8_SA
#undef PG8_SB
#undef PG8_STAGE
#undef PG8_LDA
#undef PG8_LDB
#undef PG8_MMA
#undef PG8_WAIT_V
#undef PG8_WAIT_L
#undef PG8_BAR
#undef PG8_SCHED
}
}

namespace pg8 {
__device__ __forceinline__ float silu_f(float x) { return x * __builtin_amdgcn_rcpf(1.0f + __expf(-x)); }
__device__ __forceinline__ float sigm_f(float x) { return __builtin_amdgcn_rcpf(1.0f + __expf(-x)); }
__device__ __forceinline__ float bfu2f(unsigned short u) { return __uint_as_float((unsigned)u << 16); }
struct EpiSwiGLU {
    static constexpr bool PERM = true, AFTER_DRAIN = false;
    bf16_t* H; int ldh;
    __device__ __forceinline__ void operator()(const f32x4 (&acc)[2][2][4][2], const Unit& u, int wr, int wc, int fr, int fq) const {
        const int row0 = u.pm * BM + wr * 64 + fr, col0 = u.pn * HALF + wc * 32 + 8 * fq;
#pragma unroll
        for (int ai = 0; ai < 2; ++ai)
#pragma unroll
            for (int m = 0; m < 4; ++m) {
                bf16_t* rowp = H + (size_t)(row0 + ai * HALF + m * 16) * ldh + col0;
                const f32x4 g0 = acc[ai][0][m][0], g1 = acc[ai][0][m][1], u0 = acc[ai][1][m][0], u1 = acc[ai][1][m][1];
                u32x4 w;
                w.x = cvt_pk_bf16(silu_f(g0[0]) * u0[0], silu_f(g0[1]) * u0[1]); w.y = cvt_pk_bf16(silu_f(g0[2]) * u0[2], silu_f(g0[3]) * u0[3]);
                w.z = cvt_pk_bf16(silu_f(g1[0]) * u1[0], silu_f(g1[1]) * u1[1]); w.w = cvt_pk_bf16(silu_f(g1[2]) * u1[2], silu_f(g1[3]) * u1[3]);
                *(u32x4*)rowp = w;
            }
    }
};
template <bool GATE> struct EpiResid {
    static constexpr bool PERM = true, AFTER_DRAIN = false;
    const float* res; float* out; const bf16_t* PP; float alpha, s;
    __device__ __forceinline__ void operator()(const f32x4 (&acc)[2][2][4][2], const Unit& u, int wr, int wc, int fr, int fq) const {
        const int row0 = u.pm * BM + wr * 64 + fr, col0 = u.pn * BM + wc * 32 + 8 * fq;
#pragma unroll
        for (int ai = 0; ai < 2; ++ai)
#pragma unroll
            for (int m = 0; m < 4; ++m) {
                const size_t off = (size_t)(row0 + ai * HALF + m * 16) * 1024 + col0;
#pragma unroll
                for (int bj = 0; bj < 2; ++bj) {
                    const f32x4 r0 = *(const f32x4*)(res + off + bj * HALF), r1 = *(const f32x4*)(res + off + bj * HALF + 4);
                    f32x4 a0 = acc[ai][bj][m][0], a1 = acc[ai][bj][m][1];
                    if (GATE) {
                        const u32x4 pw = *(const u32x4*)(PP + off + bj * HALF);
                        a0[0] = sigm_f(a0[0]) * __uint_as_float(pw.x << 16); a0[1] = sigm_f(a0[1]) * __uint_as_float(pw.x & 0xffff0000u);
                        a0[2] = sigm_f(a0[2]) * __uint_as_float(pw.y << 16); a0[3] = sigm_f(a0[3]) * __uint_as_float(pw.y & 0xffff0000u);
                        a1[0] = sigm_f(a1[0]) * __uint_as_float(pw.z << 16); a1[1] = sigm_f(a1[1]) * __uint_as_float(pw.z & 0xffff0000u);
                        a1[2] = sigm_f(a1[2]) * __uint_as_float(pw.w << 16); a1[3] = sigm_f(a1[3]) * __uint_as_float(pw.w & 0xffff0000u);
                    }
                    *(f32x4*)(out + off + bj * HALF) = r0 * alpha + a0 * s; *(f32x4*)(out + off + bj * HALF + 4) = r1 * alpha + a1 * s;
                }
            }
    }
};
}

#include <hip/hip_cooperative_groups.h>
namespace cg = cooperative_groups;
constexpr int NWAVES = 8;
constexpr int BATCH = 16, SEQ = 2048, D = 1024, FF = 2816, FF2 = 2 * FF, PLE = 256, NC = SEQ / 64;
constexpr int M = BATCH * SEQ;
constexpr int MIXN = 3592, MIXP = 3840;
constexpr int UQ = 0, UF = 512, UV = 1024, UG = 1536, UZ = 2048, UX = 2560, UDT = 3584;
constexpr float ALPHA = 1.189207115002721f, LN_EPS = 1e-5f, RMS_EPS = 1e-6f;
constexpr size_t MiB = 1u << 20;
constexpr size_t WS_W1IN = 1 * MiB, WS_W1OUT = 12 * MiB, WS_WMIX = 18 * MiB, WS_WOUT = 26 * MiB, WS_W2IN = 28 * MiB, WS_W2OUT = 39 * MiB, WS_WGATE = 45 * MiB, WS_WPROJ = 47 * MiB;
constexpr size_t WS_SS = 48 * MiB, WS_XB = 50 * MiB, WS_PB = 114 * MiB, WS_BIG = 130 * MiB, WS_END = 370 * MiB;
constexpr int LDS_BYTES = 135168;

#define LAS __attribute__((address_space(3)))
typedef unsigned short bf16;
typedef float f32x4 __attribute__((ext_vector_type(4)));
typedef short bf16x8 __attribute__((ext_vector_type(8)));
typedef unsigned v4u __attribute__((ext_vector_type(4)));
typedef unsigned v2u __attribute__((ext_vector_type(2)));
__device__ __forceinline__ unsigned f2bf(float f) { unsigned u = __builtin_bit_cast(unsigned, f); return (u + 0x7fffu + ((u >> 16) & 1u)) >> 16; }
__device__ __forceinline__ unsigned pk2(float lo, float hi) { return f2bf(lo) | (f2bf(hi) << 16); }
__device__ __forceinline__ float bf2f(unsigned short u) { return __uint_as_float((unsigned)u << 16); }
__device__ __forceinline__ float silu(float x) { return x * __builtin_amdgcn_rcpf(1.0f + __expf(-x)); }
__device__ __forceinline__ float wave_sum(float v) {
#pragma unroll
    for (int o = 1; o < 64; o <<= 1) v += __shfl_xor(v, o);
    return v;
}
#define MFMA16(a, b, c) __builtin_amdgcn_mfma_f32_16x16x32_bf16((a), (b), (c), 0, 0, 0)

struct Args { const float* in[26]; float* out; unsigned char* ws; int ph_lo, ph_hi; };

__device__ __forceinline__ void tr_item(const float* W, int K, int N, bf16* WT, int k0, int n0, int drow0, LAS float* scr, int lane) {
    const int nn = n0 + (lane & 31);
#pragma unroll 8
    for (int i = 0; i < 32; ++i) { const int kk = 2 * i + (lane >> 5); scr[kk * 33 + (lane & 31)] = (nn < N) ? W[(size_t)(k0 + kk) * N + nn] : 0.f; }
    asm volatile("s_waitcnt lgkmcnt(0)" ::: "memory");
    const int c = lane & 7;
#pragma unroll
    for (int j = 0; j < 4; ++j) { const int n = (lane >> 3) + 8 * j; const LAS float* s = scr + (8 * c) * 33 + n;
        v4u o; o.x = pk2(s[0 * 33], s[1 * 33]); o.y = pk2(s[2 * 33], s[3 * 33]); o.z = pk2(s[4 * 33], s[5 * 33]); o.w = pk2(s[6 * 33], s[7 * 33]);
        *(v4u*)(WT + (size_t)(drow0 + n) * K + k0 + 8 * c) = o; }
    asm volatile("s_waitcnt lgkmcnt(0)" ::: "memory");
}
__device__ __forceinline__ int swiglu_drow(int n0) { return n0 < FF ? 256 * (n0 / 128) + (n0 % 128) : 256 * ((n0 - FF) / 128) + 128 + ((n0 - FF) % 128); }

__device__ __forceinline__ void prologue(const Args& a, LAS unsigned char* lds, int gw, int NGW, int wave, int lane) {
    LAS float* scr = (LAS float*)(lds + wave * 16384);
    unsigned char* ws = a.ws;
    constexpr int I1 = (D / 64) * (FF2 / 32), I2 = (FF / 64) * (D / 32), I3 = (D / 64) * (MIXP / 32), I4 = (D / 64) * (D / 32), I8 = (PLE / 64) * (D / 32);
    constexpr int NIT = 2 * I1 + 2 * I2 + I3 + 2 * I4 + I8;
    for (int it = gw; it < NIT; it += NGW) {
        int r = it;
        if (r < 2 * I1) { const int which = r / I1; r %= I1; const int nb = r % (FF2 / 32), kb = r / (FF2 / 32);
            tr_item(a.in[which ? 18 : 2], D, FF2, (bf16*)(ws + (which ? WS_W2IN : WS_W1IN)), 64 * kb, 32 * nb, swiglu_drow(32 * nb), scr, lane); continue; }
        r -= 2 * I1;
        if (r < 2 * I2) { const int which = r / I2; r %= I2; const int nb = r % (D / 32), kb = r / (D / 32);
            tr_item(a.in[which ? 19 : 3], FF, D, (bf16*)(ws + (which ? WS_W2OUT : WS_W1OUT)), 64 * kb, 32 * nb, 32 * nb, scr, lane); continue; }
        r -= 2 * I2;
        if (r < I3) { const int nb = r % (MIXP / 32), kb = r / (MIXP / 32);
            tr_item(a.in[6], D, MIXN, (bf16*)(ws + WS_WMIX), 64 * kb, 32 * nb, 32 * nb, scr, lane); continue; }
        r -= I3;
        if (r < 2 * I4) { const int which = r / I4; r %= I4; const int nb = r % (D / 32), kb = r / (D / 32);
            tr_item(a.in[which ? 23 : 15], D, D, (bf16*)(ws + (which ? WS_WGATE : WS_WOUT)), 64 * kb, 32 * nb, 32 * nb, scr, lane); continue; }
        r -= 2 * I4;
        { const int nb = r % (D / 32), kb = r / (D / 32);
            tr_item(a.in[22], PLE, D, (bf16*)(ws + WS_WPROJ), 64 * kb, 32 * nb, 32 * nb, scr, lane); }
    }
    const float* x = a.in[0]; bf16* XB = (bf16*)(ws + WS_XB);
    for (int m = gw; m < M; m += NGW) {
        const f32x4* xr = (const f32x4*)(x + (size_t)m * D) + lane; v2u* o = (v2u*)(XB + (size_t)m * D) + lane;
#pragma unroll
        for (int j = 0; j < 4; ++j) { const f32x4 v = xr[64 * j]; v2u w; w.x = pk2(v.x, v.y); w.y = pk2(v.z, v.w); o[64 * j] = w; }
    }
    const float* p = a.in[1]; bf16* PB = (bf16*)(ws + WS_PB);
    for (int m = gw; m < M; m += NGW) {
        const f32x4 v = *((const f32x4*)(p + (size_t)m * PLE) + lane); v2u w; w.x = pk2(v.x, v.y); w.y = pk2(v.z, v.w); *((v2u*)(PB + (size_t)m * PLE) + lane) = w;
    }
}

__device__ __forceinline__ void ln_pass(float* X, const float* g, const float* b, bf16* XB, int gw, int NGW, int lane) {
    f32x4 gv[4], bv[4];
#pragma unroll
    for (int j = 0; j < 4; ++j) { gv[j] = *((const f32x4*)g + lane + 64 * j); bv[j] = *((const f32x4*)b + lane + 64 * j); }
    for (int m = gw; m < M; m += NGW) {
        f32x4* xr = (f32x4*)(X + (size_t)m * D) + lane;
        f32x4 v[4]; float s = 0.f;
#pragma unroll
        for (int j = 0; j < 4; ++j) { v[j] = xr[64 * j]; s += (v[j].x + v[j].y) + (v[j].z + v[j].w); }
        const float mean = wave_sum(s) * (1.f / D); float s2 = 0.f;
#pragma unroll
        for (int j = 0; j < 4; ++j) { v[j] = v[j] - mean; s2 += (v[j].x * v[j].x + v[j].y * v[j].y) + (v[j].z * v[j].z + v[j].w * v[j].w); }
        const float rstd = 1.f / sqrtf(wave_sum(s2) * (1.f / D) + LN_EPS);
#pragma unroll
        for (int j = 0; j < 4; ++j) { v[j] = v[j] * rstd * gv[j] + bv[j]; xr[64 * j] = v[j]; }
        if (XB) { v2u* o = (v2u*)(XB + (size_t)m * D) + lane;
#pragma unroll
            for (int j = 0; j < 4; ++j) { v2u w; w.x = pk2(v[j].x, v[j].y); w.y = pk2(v[j].z, v[j].w); o[64 * j] = w; } }
    }
}

__device__ __forceinline__ void ssd_norm_pass(bf16* O, const float* SS, const float* ng, int gw, int NGW, int lane) {
    float gv[8];
#pragma unroll
    for (int j = 0; j < 8; ++j) gv[j] = ng[8 * lane + j];
    for (int m = gw; m < M; m += NGW) {
        float s = (lane < 16) ? SS[(size_t)m * 16 + lane] : 0.f;
        s = wave_sum(s);
        const float sc = 1.f / sqrtf(s * (1.f / 512.f) + RMS_EPS);
        v4u* pp = (v4u*)(O + (size_t)m * D + 512) + lane; v4u w = *pp;
        float f[8];
        f[0] = __uint_as_float(w.x << 16); f[1] = __uint_as_float(w.x & 0xffff0000u); f[2] = __uint_as_float(w.y << 16); f[3] = __uint_as_float(w.y & 0xffff0000u);
        f[4] = __uint_as_float(w.z << 16); f[5] = __uint_as_float(w.z & 0xffff0000u); f[6] = __uint_as_float(w.w << 16); f[7] = __uint_as_float(w.w & 0xffff0000u);
#pragma unroll
        for (int j = 0; j < 8; ++j) f[j] = f[j] * sc * gv[j];
        w.x = pk2(f[0], f[1]); w.y = pk2(f[2], f[3]); w.z = pk2(f[4], f[5]); w.w = pk2(f[6], f[7]);
        *pp = w;
    }
}

constexpr int QP = 136, TP = 72;
constexpr int H_QT = 0, H_KT = H_QT + 64 * QP * 2, H_KTT = H_KT + 64 * QP * 2, H_VT = H_KTT + 128 * TP * 2, H_P = H_VT + 128 * TP * 2, H_ST = H_P + 64 * TP * 2,
              H_DV = H_ST + 128 * QP * 2, H_TOT = H_DV + 512, H_RMS = H_TOT + 2048, H_END = H_RMS + 512;
static_assert(H_END <= 131072, "hgrn lds");
__device__ __forceinline__ void hgrn_item(const Args& a, LAS unsigned char* lds, int b, int h, int tid) {
    const int lane = tid & 63, w = __builtin_amdgcn_readfirstlane(tid >> 6), l15 = lane & 15, l4 = lane >> 4;
    LAS bf16* Qt = (LAS bf16*)(lds + H_QT); LAS bf16* Kt = (LAS bf16*)(lds + H_KT); LAS bf16* KtT = (LAS bf16*)(lds + H_KTT); LAS bf16* VT = (LAS bf16*)(lds + H_VT);
    LAS bf16* P = (LAS bf16*)(lds + H_P); LAS bf16* ST = (LAS bf16*)(lds + H_ST); LAS float* dvec = (LAS float*)(lds + H_DV); LAS float* tot = (LAS float*)(lds + H_TOT); LAS float* rmsx = (LAS float*)(lds + H_RMS);
    const bf16* U = (const bf16*)(a.ws + WS_BIG); bf16* O = (bf16*)(a.ws + WS_XB);
    const int ek = tid & 127, eq = tid >> 7;
    float lb; { const float l0 = a.in[7][h * 128 + ek], l1 = a.in[7][512 + h * 128 + ek]; lb = 1.f / (1.f + __expf(l1 - l0)); }
    const float* ngp = a.in[8];
    f32x4 S[8];
#pragma unroll
    for (int j = 0; j < 8; ++j) S[j] = (f32x4){0.f, 0.f, 0.f, 0.f};
    for (int i = tid; i < 128 * QP / 2; i += 512) ((LAS unsigned*)ST)[i] = 0u;
    __syncthreads();
    for (int c = 0; c < NC; ++c) {
        const int m0 = b * SEQ + 64 * c;
        {
            const bf16* Ur = U + (size_t)(m0 + 16 * eq) * MIXP + h * 128 + ek;
            unsigned short qr[16], fr[16], vr[16];
#pragma unroll
            for (int j = 0; j < 16; ++j) { qr[j] = Ur[(size_t)j * MIXP + UQ]; fr[j] = Ur[(size_t)j * MIXP + UF]; vr[j] = Ur[(size_t)j * MIXP + UV]; }
            float bbl[16], fk[16]; float run = 0.f;
#pragma unroll
            for (int j = 0; j < 16; ++j) { const float f = lb + (1.f - lb) * __builtin_amdgcn_rcpf(1.f + __expf(-bf2f(fr[j]))); fk[j] = 1.f - f; run += __logf(f); bbl[j] = run; }
            tot[eq * 128 + ek] = run;
            __syncthreads();
            float off = 0.f, blast = 0.f;
#pragma unroll
            for (int q = 0; q < 4; ++q) { const float t = tot[q * 128 + ek]; blast += t; if (q < eq) off += t; }
            unsigned kp[8], vp[8];
#pragma unroll
            for (int j = 0; j < 16; j += 2) {
                const float b0 = bbl[j] + off, b1 = bbl[j + 1] + off;
                const unsigned q0 = f2bf(silu(bf2f(qr[j])) * __expf(b0)), q1 = f2bf(silu(bf2f(qr[j + 1])) * __expf(b1));
                const unsigned k0 = f2bf(fk[j] * __expf(-b0)), k1 = f2bf(fk[j + 1] * __expf(-b1));
                Qt[(16 * eq + j) * QP + ek] = (bf16)q0; Qt[(16 * eq + j + 1) * QP + ek] = (bf16)q1;
                Kt[(16 * eq + j) * QP + ek] = (bf16)k0; Kt[(16 * eq + j + 1) * QP + ek] = (bf16)k1;
                kp[j >> 1] = k0 | (k1 << 16); vp[j >> 1] = (unsigned)vr[j] | ((unsigned)vr[j + 1] << 16);
            }
            *(LAS v4u*)(KtT + ek * TP + 16 * eq) = (v4u){kp[0], kp[1], kp[2], kp[3]}; *(LAS v4u*)(KtT + ek * TP + 16 * eq + 8) = (v4u){kp[4], kp[5], kp[6], kp[7]};
            *(LAS v4u*)(VT + ek * TP + 16 * eq) = (v4u){vp[0], vp[1], vp[2], vp[3]}; *(LAS v4u*)(VT + ek * TP + 16 * eq + 8) = (v4u){vp[4], vp[5], vp[6], vp[7]};
            if (eq == 0) dvec[ek] = __expf(blast);
        }
        const int ti = w >> 1, vj0 = 4 * (w & 1);
        unsigned short gr[4][4];
#pragma unroll
        for (int jj = 0; jj < 4; ++jj)
#pragma unroll
            for (int i = 0; i < 4; ++i) gr[jj][i] = U[(size_t)(m0 + 16 * ti + 4 * l4 + i) * MIXP + UG + h * 128 + 16 * (vj0 + jj) + l15];
        __syncthreads();
        {
            const int sj0 = 2 * (w & 1);
#pragma unroll
            for (int jj = 0; jj < 2; ++jj) {
                const int sj = sj0 + jj; f32x4 acc = (f32x4){0.f, 0.f, 0.f, 0.f};
                if (sj <= ti) {
#pragma unroll
                    for (int kk = 0; kk < 4; ++kk) { const bf16x8 af = *(const LAS bf16x8*)(Qt + (16 * ti + l15) * QP + 32 * kk + 8 * l4), bfr = *(const LAS bf16x8*)(Kt + (16 * sj + l15) * QP + 32 * kk + 8 * l4); acc = MFMA16(af, bfr, acc); }
                }
#pragma unroll
                for (int i = 0; i < 4; ++i) { const int t = 16 * ti + 4 * l4 + i, s = 16 * sj + l15; P[t * TP + s] = (bf16)f2bf(s <= t ? acc[i] : 0.f); }
            }
        }
        __syncthreads();
        {
            f32x4 o[4];
#pragma unroll
            for (int jj = 0; jj < 4; ++jj) {
                const int vj = vj0 + jj; f32x4 acc = (f32x4){0.f, 0.f, 0.f, 0.f};
#pragma unroll
                for (int kk = 0; kk < 2; ++kk) { const bf16x8 af = *(const LAS bf16x8*)(P + (16 * ti + l15) * TP + 32 * kk + 8 * l4), bfr = *(const LAS bf16x8*)(VT + (16 * vj + l15) * TP + 32 * kk + 8 * l4); acc = MFMA16(af, bfr, acc); }
#pragma unroll
                for (int kk = 0; kk < 4; ++kk) { const bf16x8 af = *(const LAS bf16x8*)(Qt + (16 * ti + l15) * QP + 32 * kk + 8 * l4), bfr = *(const LAS bf16x8*)(ST + (16 * vj + l15) * QP + 32 * kk + 8 * l4); acc = MFMA16(af, bfr, acc); }
                o[jj] = acc;
            }
            float ss[4];
#pragma unroll
            for (int i = 0; i < 4; ++i) { float s = 0.f;
#pragma unroll
                for (int jj = 0; jj < 4; ++jj) s += o[jj][i] * o[jj][i];
                s += __shfl_xor(s, 1); s += __shfl_xor(s, 2); s += __shfl_xor(s, 4); s += __shfl_xor(s, 8); ss[i] = s; }
            if (l15 == 0) {
#pragma unroll
                for (int i = 0; i < 4; ++i) rmsx[(w & 1) * 64 + 16 * ti + 4 * l4 + i] = ss[i];
            }
            __syncthreads();
#pragma unroll
            for (int i = 0; i < 4; ++i) { const int t = 16 * ti + 4 * l4 + i; const float tot2 = rmsx[t] + rmsx[64 + t]; const float rstd = 1.f / sqrtf(tot2 * (1.f / 128.f) + RMS_EPS);
#pragma unroll
                for (int jj = 0; jj < 4; ++jj) { const int v = 16 * (vj0 + jj) + l15; const float val = o[jj][i] * rstd * ngp[v] * silu(bf2f(gr[jj][i]));
                    O[(size_t)(m0 + t) * D + h * 128 + v] = (bf16)f2bf(val); } }
        }
        {
#pragma unroll
            for (int vj = 0; vj < 8; ++vj) {
#pragma unroll
                for (int kk = 0; kk < 2; ++kk) { const bf16x8 af = *(const LAS bf16x8*)(KtT + (16 * w + l15) * TP + 32 * kk + 8 * l4), bfr = *(const LAS bf16x8*)(VT + (16 * vj + l15) * TP + 32 * kk + 8 * l4); S[vj] = MFMA16(af, bfr, S[vj]); }
            }
            const f32x4 dv = *(const LAS f32x4*)(dvec + 16 * w + 4 * l4);
#pragma unroll
            for (int vj = 0; vj < 8; ++vj) { S[vj] = S[vj] * dv; v2u pk; pk.x = pk2(S[vj][0], S[vj][1]); pk.y = pk2(S[vj][2], S[vj][3]); *(LAS v2u*)(ST + (16 * vj + l15) * QP + 16 * w + 4 * l4) = pk; }
        }
    }
    __syncthreads();
}

constexpr int S_CQ = 0, S_BK = S_CQ + 64 * QP * 2, S_BT = S_BK + 64 * QP * 2, S_XT = S_BT + 128 * TP * 2, S_XS = S_XT + 64 * TP * 2, S_G = S_XS + 64 * TP * 2, S_HB = S_G + 64 * TP * 2,
              S_AC = S_HB + 64 * QP * 2, S_DT = S_AC + 256, S_END = S_DT + 256;
static_assert(S_END <= 131072, "ssd lds");
__device__ __forceinline__ void ssd_item(const Args& a, LAS unsigned char* lds, int b, int hd, int tid) {
    const int lane = tid & 63, w = __builtin_amdgcn_readfirstlane(tid >> 6), l15 = lane & 15, l4 = lane >> 4, g = hd >> 2;
    LAS bf16* Cq = (LAS bf16*)(lds + S_CQ); LAS bf16* Bk = (LAS bf16*)(lds + S_BK); LAS bf16* BT = (LAS bf16*)(lds + S_BT); LAS bf16* XT = (LAS bf16*)(lds + S_XT);
    LAS bf16* XS = (LAS bf16*)(lds + S_XS); LAS bf16* G = (LAS bf16*)(lds + S_G); LAS bf16* Hb = (LAS bf16*)(lds + S_HB); LAS float* acum = (LAS float*)(lds + S_AC); LAS float* dtv = (LAS float*)(lds + S_DT);
    const bf16* U = (const bf16*)(a.ws + WS_BIG); bf16* O = (bf16*)(a.ws + WS_XB); float* SS = (float*)(a.ws + WS_SS);
    const float* cw = a.in[9]; const float* cbias = a.in[10];
    const int ch = tid & 255, half = tid >> 8, isC = (ch >> 7), n = ch & 127;
    const int cbc = 512 + isC * 256 + g * 128 + n;
    const float w0 = cw[cbc], w1 = cw[1024 + cbc], w2 = cw[2048 + cbc], w3 = cw[3072 + cbc], wb = cbias[cbc];
    const int cx = hd * 64 + lane;
    const float x0w = cw[cx], x1w = cw[1024 + cx], x2w = cw[2048 + cx], x3w = cw[3072 + cx], xb = cbias[cx];
    const float Aneg = -__expf(a.in[12][hd]), dtb = a.in[11][hd], Dsk = a.in[13][hd];
    f32x4 Hs[4];
#pragma unroll
    for (int j = 0; j < 4; ++j) Hs[j] = (f32x4){0.f, 0.f, 0.f, 0.f};
    for (int i = tid; i < 64 * QP / 2; i += 512) ((LAS unsigned*)Hb)[i] = 0u;
    __syncthreads();
    for (int c = 0; c < NC; ++c) {
        const int m0 = b * SEQ + 64 * c;
        float dt, ac, wdec;
        {
            const float dr = bf2f(U[(size_t)(m0 + lane) * MIXP + UDT + hd]) + dtb;
            dt = dr > 20.f ? dr : __logf(1.f + __expf(dr));
            ac = Aneg * dt;
#pragma unroll
            for (int o = 1; o < 64; o <<= 1) { const float t = __shfl_up(ac, o); if (lane >= o) ac += t; }
            const float aclast = __shfl(ac, 63);
            wdec = dt * __expf(aclast - ac);
            if (w == 0) { acum[lane] = ac; dtv[lane] = dt; }
        }
        {
            const int t0 = 32 * half;
            const bf16* Uc = U + (size_t)(m0 + t0) * MIXP + UX + cbc;
            const bool first = (c == 0 && half == 0);
            float xm3 = first ? 0.f : bf2f(*(Uc - 3 * (ptrdiff_t)MIXP)), xm2 = first ? 0.f : bf2f(*(Uc - 2 * (ptrdiff_t)MIXP)), xm1 = first ? 0.f : bf2f(*(Uc - (ptrdiff_t)MIXP));
            LAS bf16* dst = isC ? Cq : Bk;
#pragma unroll
            for (int j8 = 0; j8 < 4; ++j8) {
                unsigned pk[4];
#pragma unroll
                for (int j = 0; j < 8; ++j) {
                    const float xc = bf2f(Uc[(size_t)(8 * j8 + j) * MIXP]);
                    const float o = silu(wb + w0 * xm3 + w1 * xm2 + w2 * xm1 + w3 * xc);
                    xm3 = xm2; xm2 = xm1; xm1 = xc;
                    const unsigned ob = f2bf(o);
                    dst[(t0 + 8 * j8 + j) * QP + n] = (bf16)ob;
                    if (j & 1) pk[j >> 1] |= ob << 16; else pk[j >> 1] = ob;
                }
                if (!isC) *(LAS v4u*)(BT + n * TP + t0 + 8 * j8) = (v4u){pk[0], pk[1], pk[2], pk[3]};
            }
        }
        {
            const int t0 = 8 * w;
            const bf16* Uc = U + (size_t)(m0 + t0) * MIXP + UX + cx;
            const bool first = (c == 0 && w == 0);
            float xm3 = first ? 0.f : bf2f(*(Uc - 3 * (ptrdiff_t)MIXP)), xm2 = first ? 0.f : bf2f(*(Uc - 2 * (ptrdiff_t)MIXP)), xm1 = first ? 0.f : bf2f(*(Uc - (ptrdiff_t)MIXP));
            unsigned pk[4], ps[4];
#pragma unroll
            for (int j = 0; j < 8; ++j) {
                const float xc = bf2f(Uc[(size_t)j * MIXP]);
                const float o = silu(xb + x0w * xm3 + x1w * xm2 + x2w * xm1 + x3w * xc);
                xm3 = xm2; xm2 = xm1; xm1 = xc;
                const float wt = __shfl(wdec, t0 + j);
                const unsigned ob = f2bf(o), os = f2bf(o * wt);
                if (j & 1) { pk[j >> 1] |= ob << 16; ps[j >> 1] |= os << 16; } else { pk[j >> 1] = ob; ps[j >> 1] = os; }
            }
            *(LAS v4u*)(XT + lane * TP + t0) = (v4u){pk[0], pk[1], pk[2], pk[3]};
            *(LAS v4u*)(XS + lane * TP + t0) = (v4u){ps[0], ps[1], ps[2], ps[3]};
        }
        const int ti = w >> 1, pj0 = 2 * (w & 1);
        unsigned short zr[2][4];
#pragma unroll
        for (int jj = 0; jj < 2; ++jj)
#pragma unroll
            for (int i = 0; i < 4; ++i) zr[jj][i] = U[(size_t)(m0 + 16 * ti + 4 * l4 + i) * MIXP + UZ + hd * 64 + 16 * (pj0 + jj) + l15];
        __syncthreads();
        {
            const int sj0 = 2 * (w & 1);
#pragma unroll
            for (int jj = 0; jj < 2; ++jj) {
                const int sj = sj0 + jj; f32x4 acc = (f32x4){0.f, 0.f, 0.f, 0.f};
                if (sj <= ti) {
#pragma unroll
                    for (int kk = 0; kk < 4; ++kk) { const bf16x8 af = *(const LAS bf16x8*)(Cq + (16 * ti + l15) * QP + 32 * kk + 8 * l4), bfr = *(const LAS bf16x8*)(Bk + (16 * sj + l15) * QP + 32 * kk + 8 * l4); acc = MFMA16(af, bfr, acc); }
                }
                const int s = 16 * sj + l15; const float as = acum[s], ds = dtv[s];
#pragma unroll
                for (int i = 0; i < 4; ++i) { const int t = 16 * ti + 4 * l4 + i; const float at = acum[t];
                    G[t * TP + s] = (bf16)f2bf(s <= t ? acc[i] * __expf(at - as) * ds : 0.f); }
            }
        }
        __syncthreads();
        {
            float sq[4] = {0.f, 0.f, 0.f, 0.f};
#pragma unroll
            for (int jj = 0; jj < 2; ++jj) {
                const int pj = pj0 + jj; f32x4 a1 = (f32x4){0.f, 0.f, 0.f, 0.f}, a2 = (f32x4){0.f, 0.f, 0.f, 0.f};
#pragma unroll
                for (int kk = 0; kk < 2; ++kk) { const bf16x8 af = *(const LAS bf16x8*)(G + (16 * ti + l15) * TP + 32 * kk + 8 * l4), bfr = *(const LAS bf16x8*)(XT + (16 * pj + l15) * TP + 32 * kk + 8 * l4); a1 = MFMA16(af, bfr, a1); }
#pragma unroll
                for (int kk = 0; kk < 4; ++kk) { const bf16x8 af = *(const LAS bf16x8*)(Cq + (16 * ti + l15) * QP + 32 * kk + 8 * l4), bfr = *(const LAS bf16x8*)(Hb + (16 * pj + l15) * QP + 32 * kk + 8 * l4); a2 = MFMA16(af, bfr, a2); }
                const v2u xw = *(const LAS v2u*)(XT + (16 * pj + l15) * TP + 16 * ti + 4 * l4);
                float xs[4]; xs[0] = __uint_as_float(xw.x << 16); xs[1] = __uint_as_float(xw.x & 0xffff0000u); xs[2] = __uint_as_float(xw.y << 16); xs[3] = __uint_as_float(xw.y & 0xffff0000u);
#pragma unroll
                for (int i = 0; i < 4; ++i) { const int t = 16 * ti + 4 * l4 + i; const float y = a1[i] + __expf(acum[t]) * a2[i] + Dsk * xs[i];
                    const float yg = y * silu(bf2f(zr[jj][i])); sq[i] += yg * yg;
                    O[(size_t)(m0 + t) * D + 512 + hd * 64 + 16 * pj + l15] = (bf16)f2bf(yg); }
            }
#pragma unroll
            for (int i = 0; i < 4; ++i) { float s = sq[i]; s += __shfl_xor(s, 1); s += __shfl_xor(s, 2); s += __shfl_xor(s, 4); s += __shfl_xor(s, 8); sq[i] = s; }
            if (l15 == 0) {
#pragma unroll
                for (int i = 0; i < 4; ++i) SS[(size_t)(m0 + 16 * ti + 4 * l4 + i) * 16 + hd * 2 + (w & 1)] = sq[i];
            }
        }
        {
            const float cd = __expf(acum[63]);
#pragma unroll
            for (int pj = 0; pj < 4; ++pj) {
                Hs[pj] = Hs[pj] * cd;
#pragma unroll
                for (int kk = 0; kk < 2; ++kk) { const bf16x8 af = *(const LAS bf16x8*)(BT + (16 * w + l15) * TP + 32 * kk + 8 * l4), bfr = *(const LAS bf16x8*)(XS + (16 * pj + l15) * TP + 32 * kk + 8 * l4); Hs[pj] = MFMA16(af, bfr, Hs[pj]); }
            }
            __syncthreads();
#pragma unroll
            for (int pj = 0; pj < 4; ++pj) { v2u pk; pk.x = pk2(Hs[pj][0], Hs[pj][1]); pk.y = pk2(Hs[pj][2], Hs[pj][3]); *(LAS v2u*)(Hb + (16 * pj + l15) * QP + 16 * w + 4 * l4) = pk; }
        }
    }
    __syncthreads();
}

__global__ void __launch_bounds__(NWAVES * 64, 2) fwd_kernel(Args args) {
    extern __shared__ __attribute__((aligned(16))) unsigned char lds_raw[];
    LAS unsigned char* lds = (LAS unsigned char*)lds_raw;
    cg::grid_group grid = cg::this_grid();
    const int tid = threadIdx.x, lane = tid & 63, wave = __builtin_amdgcn_readfirstlane(tid >> 6);
    const int G = gridDim.x, gw = blockIdx.x * NWAVES + wave, NGW = G * NWAVES;
    unsigned char* ws = args.ws;
    bf16* XB = (bf16*)(ws + WS_XB); bf16* PB = (bf16*)(ws + WS_PB); bf16* BIG = (bf16*)(ws + WS_BIG);
    float* X = args.out;
    const int lo = args.ph_lo, hi = args.ph_hi;
#define IN(k) (lo <= (k) && (k) < hi)
#define SEAM(k) do { if (IN(k) && IN((k) + 1)) grid.sync(); } while (0)
    if (IN(0)) { prologue(args, lds, gw, NGW, wave, lane); __syncthreads(); }
    SEAM(0);
    if (IN(1)) { pg8::Gemm g{XB, (const bf16*)(ws + WS_W1IN), M, FF2, D}; pg8::StaticOrder S; S.init(M, FF2, G, (int)blockIdx.x);
        pg8::EpiSwiGLU E{BIG, FF}; pg8::gemm_phase<pg8::EpiSwiGLU, pg8::StaticOrder, true, true>(lds, g, S, E); }
    SEAM(1);
    if (IN(2)) { pg8::Gemm g{BIG, (const bf16*)(ws + WS_W1OUT), M, D, FF}; pg8::StaticOrder S; S.init(M, D, G, (int)blockIdx.x);
        pg8::EpiResid<false> E{args.in[0], X, nullptr, ALPHA, 0.5f}; pg8::gemm_phase<pg8::EpiResid<false>, pg8::StaticOrder, true, true>(lds, g, S, E); }
    SEAM(2);
    if (IN(3)) ln_pass(X, args.in[4], args.in[5], XB, gw, NGW, lane);
    SEAM(3);
    if (IN(4)) { pg8::Gemm g{XB, (const bf16*)(ws + WS_WMIX), M, MIXP, D}; pg8::StaticOrder S; S.init(M, MIXP, G, (int)blockIdx.x);
        pg8::EpiBf16<0> E{BIG, MIXP, nullptr, 0, 0, 1.f}; pg8::gemm_phase<pg8::EpiBf16<0>, pg8::StaticOrder, true, true>(lds, g, S, E); }
    SEAM(4);
    if (IN(5)) {
        for (int it = blockIdx.x; it < 192; it += G) {
            if (it < 64) hgrn_item(args, lds, it >> 2, it & 3, tid);
            else ssd_item(args, lds, (it - 64) >> 3, (it - 64) & 7, tid);
        }
    }
    SEAM(5);
    if (IN(6)) ssd_norm_pass(XB, (const float*)(ws + WS_SS), args.in[14], gw, NGW, lane);
    SEAM(6);
    if (IN(7)) { pg8::Gemm g{XB, (const bf16*)(ws + WS_WOUT), M, D, D}; pg8::StaticOrder S; S.init(M, D, G, (int)blockIdx.x);
        pg8::EpiResid<false> E{X, X, nullptr, ALPHA, 1.0f}; pg8::gemm_phase<pg8::EpiResid<false>, pg8::StaticOrder, true, true>(lds, g, S, E); }
    SEAM(7);
    if (IN(8)) ln_pass(X, args.in[16], args.in[17], XB, gw, NGW, lane);
    SEAM(8);
    if (IN(9)) { pg8::Gemm g{XB, (const bf16*)(ws + WS_W2IN), M, FF2, D}; pg8::StaticOrder S; S.init(M, FF2, G, (int)blockIdx.x);
        pg8::EpiSwiGLU E{BIG, FF}; pg8::gemm_phase<pg8::EpiSwiGLU, pg8::StaticOrder, true, true>(lds, g, S, E); }
    SEAM(9);
    if (IN(10)) { pg8::Gemm g{BIG, (const bf16*)(ws + WS_W2OUT), M, D, FF}; pg8::StaticOrder S; S.init(M, D, G, (int)blockIdx.x);
        pg8::EpiResid<false> E{X, X, nullptr, ALPHA, 0.5f}; pg8::gemm_phase<pg8::EpiResid<false>, pg8::StaticOrder, true, true>(lds, g, S, E); }
    SEAM(10);
    if (IN(11)) ln_pass(X, args.in[20], args.in[21], XB, gw, NGW, lane);
    SEAM(11);
    if (IN(12)) { pg8::Gemm g{PB, (const bf16*)(ws + WS_WPROJ), M, D, PLE}; pg8::StaticOrder S; S.init(M, D, G, (int)blockIdx.x);
        pg8::EpiBf16<0> E{BIG, D, nullptr, 0, 0, 1.f}; pg8::gemm_phase<pg8::EpiBf16<0>, pg8::StaticOrder, true, true>(lds, g, S, E); }
    SEAM(12);
    if (IN(13)) { pg8::Gemm g{XB, (const bf16*)(ws + WS_WGATE), M, D, D}; pg8::StaticOrder S; S.init(M, D, G, (int)blockIdx.x);
        pg8::EpiResid<true> E{X, X, BIG, ALPHA, 1.0f}; pg8::gemm_phase<pg8::EpiResid<true>, pg8::StaticOrder, true, true>(lds, g, S, E); }
    SEAM(13);
    if (IN(14)) ln_pass(X, args.in[24], args.in[25], nullptr, gw, NGW, lane);
#undef IN
#undef SEAM
}

constexpr int NPHASE = 15;
#ifndef MK_PER_PHASE
#define MK_PER_PHASE 0
#endif
extern "C" void kernel_launch(void* const* d_in, const int* in_sizes, int n_in, void* d_out, int out_size, void* d_ws, size_t ws_size, hipStream_t stream) {
    static int grid = 0;
    if (grid == 0) {
        if (n_in != 26 || in_sizes[0] != M * D || out_size != M * D || ws_size < WS_END) { fprintf(stderr, "kernel_launch: unexpected shapes (n_in %d, in0 %d, out %d, ws %zu)\n", n_in, n_in > 0 ? in_sizes[0] : -1, out_size, ws_size); grid = -1; return; }
        int dev = 0, cus = 0, per_cu = 0;
        hipGetDevice(&dev); hipDeviceGetAttribute(&cus, hipDeviceAttributeMultiprocessorCount, dev);
        if (hipFuncSetAttribute((const void*)fwd_kernel, hipFuncAttributeMaxDynamicSharedMemorySize, LDS_BYTES) != hipSuccess) { fprintf(stderr, "kernel_launch: hipFuncSetAttribute failed\n"); grid = -1; return; }
        if (hipOccupancyMaxActiveBlocksPerMultiprocessor(&per_cu, (const void*)fwd_kernel, NWAVES * 64, LDS_BYTES) != hipSuccess || per_cu < 1) { fprintf(stderr, "kernel_launch: occupancy query says %d\n", per_cu); per_cu = 1; }
        (void)hipGetLastError();
        grid = cus * (per_cu > 1 ? 1 : per_cu);
        if (grid <= 0) grid = 256;
    }
    if (grid < 0) return;
    Args a{};
    for (int i = 0; i < 26; ++i) a.in[i] = (const float*)d_in[i];
    a.out = (float*)d_out; a.ws = (unsigned char*)d_ws;
#if MK_PER_PHASE
    for (int ph = 0; ph < NPHASE; ++ph) { a.ph_lo = ph; a.ph_hi = ph + 1; hipLaunchKernelGGL(fwd_kernel, dim3(grid), dim3(NWAVES * 64), LDS_BYTES, stream, a); }
#else
    a.ph_lo = 0; a.ph_hi = NPHASE;
    void* kargs[] = {&a};
    hipError_t e = hipLaunchCooperativeKernel((const void*)fwd_kernel, dim3(grid), dim3(NWAVES * 64), kargs, LDS_BYTES, stream);
    if (e != hipSuccess) fprintf(stderr, "cooperative launch failed: %s (grid %d)\n", hipGetErrorString(e), grid);
#endif
}
```

```cpp
#include <hip/hip_runtime.h>
#include <cstdio>
#include <cstdint>
namespace pg8 {
#define PG8_LAS __attribute__((address_space(3)))
typedef unsigned short bf16_t;
typedef short bf16x8 __attribute__((ext_vector_type(8)));
typedef float f32x4 __attribute__((ext_vector_type(4)));
typedef unsigned u32x4 __attribute__((ext_vector_type(4)));
constexpr int BM = 256, BK = 64, HALF = 128, HTB = HALF * BK * 2  , STAGE_BYTES = 8 * HTB, NXCD = 8, WGM = 8;

__host__ __device__ __forceinline__ int lds_byte(int r, int c) { const int st = (r >> 4) * 2 + (c >> 5), rr = r & 15, cc = c & 31, ob = rr * 64 + cc * 2; return st * 1024 + (ob ^ (((ob >> 9) & 1) << 5)); }
__host__ __device__ __forceinline__ void stage_rc(int b, int& R, int& C) { const int st = b / 1024, sb = b % 1024, swz = sb ^ (((sb >> 9) & 1) << 5); R = (st >> 1) * 16 + swz / 64; C = (st & 1) * 32 + (swz % 64) / 2; }
__host__ __device__ __forceinline__ int perm32(int rho) { const int n = rho >> 4, i = rho & 15; return 8 * (i >> 2) + 4 * n + (i & 3); }

struct Unit { int pm, pn; };
struct Gemm { const bf16_t* A; const bf16_t* Bt; int M, N, K; };

struct StaticOrder {
    int nM, nN, nwg, G, c;
    __host__ __device__ void init(int M, int N, int G_, int c_) { nM = M / BM; nN = N / BM; nwg = nM * nN; G = G_; c = c_; }
    __host__ __device__ bool next(int i, Unit& u) const {
        const long L = (long)i * G + c; if (L >= nwg) return false;
        int wgid = (int)L; { const int q = nwg / NXCD, r = nwg % NXCD, xcd = wgid % NXCD, off = wgid / NXCD; wgid = (xcd < r ? xcd * (q + 1) : r * (q + 1) + (xcd - r) * q) + off; }
        const int nig = WGM * nN, gid = wgid / nig, fm = gid * WGM, gsz = (nM - fm) < WGM ? (nM - fm) : WGM;
        u.pm = fm + ((wgid % nig) % gsz); u.pn = (wgid % nig) / gsz; return true;
    }
    __device__ __forceinline__ void a_ready(const Unit&) const {}
    __device__ __forceinline__ void done(const Unit&) const {}
};

__device__ __forceinline__ unsigned cvt_pk_bf16(float lo, float hi) { unsigned r; asm volatile("v_cvt_pk_bf16_f32 %0, %1, %2" : "=v"(r) : "v"(lo), "v"(hi)); return r; }
typedef float f32x2 __attribute__((ext_vector_type(2)));
__device__ __forceinline__ f32x2 gelu_pk(f32x2 v) {
    const f32x2 av = __builtin_elementwise_abs(v), d = av * 0.2316418882f + 1.0f;
    f32x2 t; t.x = __builtin_amdgcn_rcpf(d.x); t.y = __builtin_amdgcn_rcpf(d.y);
    f32x2 q = t * 0.5307027145f + (-0.7265760135f); q = q * t + 0.7107068705f; q = q * t + (-0.142248368f); q = q * t + 0.127414796f; q = q * t;
    const f32x2 s = (v * v) * (-0.72134752044f);
    f32x2 e; e.x = __builtin_amdgcn_exp2f(s.x); e.y = __builtin_amdgcn_exp2f(s.y);
    const f32x2 m = v * (q * e), r = v - m;
    f32x2 o; o.x = v.x < 0.f ? m.x : r.x; o.y = v.y < 0.f ? m.y : r.y; return o;
}

template <int ACT  > struct EpiBf16 {
    static constexpr bool PERM = true, AFTER_DRAIN = false; static_assert(ACT == 0 || ACT == 1, "EpiBf16: ACT is 0 (none) or 1 (gelu_pk)");
    bf16_t* O; int ldc; const float* bias; int split_cols; size_t split_stride; float scale0;
    __device__ __forceinline__ void operator()(const f32x4 (&acc)[2][2][4][2], const Unit& u, int wr, int wc, int fr, int fq) const {
        const int row0 = u.pm * BM + wr * 64 + fr; int colt = u.pn * BM; bf16_t* base = O;
        float sc = 1.f; if (split_cols) { const int t = colt / split_cols; base += (size_t)t * split_stride; colt -= t * split_cols; if (t == 0) sc = scale0; }
        const int col0 = colt + wc * 32 + 8 * fq, bcol0 = u.pn * BM + wc * 32 + 8 * fq;
        f32x4 bv[2][2];
#pragma unroll
        for (int bj = 0; bj < 2; ++bj)
#pragma unroll
            for (int n = 0; n < 2; ++n) bv[bj][n] = bias ? *(const f32x4*)(bias + bcol0 + bj * HALF + 4 * n) : (f32x4){0.f, 0.f, 0.f, 0.f};
#pragma unroll
        for (int ai = 0; ai < 2; ++ai)
#pragma unroll
            for (int m = 0; m < 4; ++m) { bf16_t* rowp = base + (size_t)(row0 + ai * HALF + m * 16) * ldc + col0;
#pragma unroll
                for (int bj = 0; bj < 2; ++bj) { f32x4 v0 = acc[ai][bj][m][0] + bv[bj][0], v1 = acc[ai][bj][m][1] + bv[bj][1];
                    if (ACT == 1) { f32x2 a = gelu_pk((f32x2){v0[0], v0[1]}), b = gelu_pk((f32x2){v0[2], v0[3]}), c = gelu_pk((f32x2){v1[0], v1[1]}), d = gelu_pk((f32x2){v1[2], v1[3]});
                        v0 = (f32x4){a.x, a.y, b.x, b.y}; v1 = (f32x4){c.x, c.y, d.x, d.y}; }
                    v0 = v0 * sc; v1 = v1 * sc; u32x4 w; w.x = cvt_pk_bf16(v0[0], v0[1]); w.y = cvt_pk_bf16(v0[2], v0[3]); w.z = cvt_pk_bf16(v1[0], v1[1]); w.w = cvt_pk_bf16(v1[2], v1[3]);
                    *(u32x4*)(rowp + bj * HALF) = w; } }
    }
};

struct PanelStats {
    unsigned* xbuf;
    unsigned* cnt;
    unsigned* tmo;
    int ntn; float eps;
    unsigned code;
    __device__ __forceinline__ bool run(const f32x4 (&v)[2][2][4][2], const Unit& u, int wr, int wc, int fr, int fq, PG8_LAS unsigned char* lds, int wid, int lane) const {
        typedef float f32x2v __attribute__((ext_vector_type(2)));
        PG8_LAS f32x2v* P = (PG8_LAS f32x2v*)lds;
        PG8_LAS f32x2v* S = (PG8_LAS f32x2v*)(lds + 8192);
        PG8_LAS unsigned* flag = (PG8_LAS unsigned*)(lds + 8192 + 2048);
#pragma unroll
        for (int ai = 0; ai < 2; ++ai)
#pragma unroll
            for (int m = 0; m < 4; ++m) {
                float s = 0.f;
#pragma unroll
                for (int bj = 0; bj < 2; ++bj)
#pragma unroll
                    for (int n = 0; n < 2; ++n) { const f32x4 x = v[ai][bj][m][n]; s += (x[0] + x[1]) + (x[2] + x[3]); }
                s += __shfl_xor(s, 16); s += __shfl_xor(s, 32);
                const float mw = s * (1.0f / 64.0f); float q = 0.f;
#pragma unroll
                for (int bj = 0; bj < 2; ++bj)
#pragma unroll
                    for (int n = 0; n < 2; ++n) { const f32x4 d = v[ai][bj][m][n] - mw; q += (d[0] * d[0] + d[1] * d[1]) + (d[2] * d[2] + d[3] * d[3]); }
                q += __shfl_xor(q, 16); q += __shfl_xor(q, 32);
                if (fq == 0) P[(ai * HALF + wr * 64 + m * 16 + fr) * 4 + wc] = (f32x2v){mw, q};
            }
        asm volatile("s_waitcnt lgkmcnt(0)" ::: "memory"); __builtin_amdgcn_s_barrier(); asm volatile("" ::: "memory");
#if defined(BROKEN_EXCHANGE_NO_WAIT)
#warning BROKEN CONTROL BUILD: the row-statistics exchange does not wait; results are wrong by design
        if (blockIdx.x >= 64) { const long long t0_ = clock64(); while (clock64() - t0_ < 60000) __builtin_amdgcn_s_sleep(8); }
#endif
        const int row = wid * 32 + (lane & 31);
        if (lane < 32) {
            const f32x2v a = P[row * 4 + 0], b = P[row * 4 + 1], c = P[row * 4 + 2], d = P[row * 4 + 3];
            const float mt = (a.x + b.x + c.x + d.x) * 0.25f;
            const float da = a.x - mt, db = b.x - mt, dc = c.x - mt, dd = d.x - mt;
            const float m2 = (a.y + b.y) + (c.y + d.y) + 64.0f * ((da * da + db * db) + (dc * dc + dd * dd));
            unsigned long long* slot = (unsigned long long*)xbuf + ((size_t)(u.pm * BM + row) * 4 + u.pn);
            __hip_atomic_store(slot, ((unsigned long long)__float_as_uint(m2) << 32) | __float_as_uint(mt), __ATOMIC_RELAXED, __HIP_MEMORY_SCOPE_AGENT);
        }
        asm volatile("s_waitcnt vmcnt(0)" ::: "memory");
        if (lane == 0) __hip_atomic_fetch_add(cnt + 64 * u.pm, 1u, __ATOMIC_RELAXED, __HIP_MEMORY_SCOPE_AGENT);
        if (wid == 0) {
            bool dead = false; const unsigned long long t0 = __builtin_amdgcn_s_memrealtime(); const unsigned want = 8u * (unsigned)ntn;
            for (;;) {
#if defined(BROKEN_EXCHANGE_NO_WAIT)
                break;
#endif
                if ((unsigned)__builtin_amdgcn_readfirstlane(__hip_atomic_load(cnt + 64 * u.pm, __ATOMIC_RELAXED, __HIP_MEMORY_SCOPE_AGENT)) >= want) break;
                if (__builtin_amdgcn_s_memrealtime() - t0 > 2000000ull) {
                    if (lane == 0) { unsigned expect = 0u; __hip_atomic_compare_exchange_strong(tmo + 1, &expect, code | (unsigned)(u.pm & 0xff), __ATOMIC_RELAXED, __ATOMIC_RELAXED, __HIP_MEMORY_SCOPE_AGENT);
                                     __hip_atomic_store(tmo, 1u, __ATOMIC_RELAXED, __HIP_MEMORY_SCOPE_AGENT); }
                    dead = true; break; }
                __builtin_amdgcn_s_sleep(2);
            }
            __builtin_amdgcn_fence(__ATOMIC_ACQUIRE, "agent");
            if (lane == 0) flag[0] = dead ? 1u : 0u;
        }
        asm volatile("s_waitcnt vmcnt(0) lgkmcnt(0)" ::: "memory"); __builtin_amdgcn_s_barrier(); asm volatile("" ::: "memory");
        const bool bad = flag[0] != 0u;
        if (lane < 32) {
            const unsigned long long* slot = (const unsigned long long*)xbuf + (size_t)(u.pm * BM + row) * 4; float mt[4], m2[4]; float ms = 0.f;
#pragma unroll
            for (int t = 0; t < 4; ++t) { if (t < ntn) { const unsigned long long w = __hip_atomic_load(slot + t, __ATOMIC_RELAXED, __HIP_MEMORY_SCOPE_AGENT); mt[t] = __uint_as_float((unsigned)w); m2[t] = __uint_as_float((unsigned)(w >> 32)); } else { mt[t] = 0.f; m2[t] = 0.f; } ms += mt[t]; }
            const float mean = ms / (float)ntn; float q = 0.f;
#pragma unroll
            for (int t = 0; t < 4; ++t) if (t < ntn) { const float dm = mt[t] - mean; q += m2[t] + 256.0f * dm * dm; }
            S[row] = (f32x2v){mean, 1.0f / sqrtf(q / (256.0f * (float)ntn) + eps)};
        }
        asm volatile("s_waitcnt lgkmcnt(0)" ::: "memory"); __builtin_amdgcn_s_barrier(); asm volatile("" ::: "memory");
        return bad;
    }
};
struct EpiLnRes {
    static constexpr bool PERM = false, AFTER_DRAIN = true;
    const float* base; float* out; int ldc; const float* bias; PanelStats st; unsigned poison;
    __device__ __forceinline__ void fused(f32x4 (&acc)[2][2][4][2], const Unit& u, int wr, int wc, int fr, int fq, PG8_LAS unsigned char* lds, int wid, int lane) const {
        typedef float f32x2v __attribute__((ext_vector_type(2)));
        const PG8_LAS f32x2v* S = (const PG8_LAS f32x2v*)(lds + 8192);
        const int col0 = u.pn * BM + wc * 32 + 4 * fq;
#pragma unroll
        for (int bj = 0; bj < 2; ++bj)
#pragma unroll
            for (int n = 0; n < 2; ++n) { const f32x4 bv = bias ? *(const f32x4*)(bias + col0 + bj * HALF + n * 16) : (f32x4){0.f, 0.f, 0.f, 0.f};
#pragma unroll
                for (int ai = 0; ai < 2; ++ai)
#pragma unroll
                    for (int m = 0; m < 4; ++m) acc[ai][bj][m][n] += bv; }
        f32x4 pre[4][2][2];
#pragma unroll
        for (int m = 0; m < 4; ++m) { const size_t off = (size_t)(u.pm * BM + wr * 64 + m * 16 + fr) * ldc + col0;
#pragma unroll
            for (int bj = 0; bj < 2; ++bj)
#pragma unroll
                for (int n = 0; n < 2; ++n) pre[m][bj][n] = *(const f32x4*)(base + off + bj * HALF + n * 16); }
        const bool bad = st.run(acc, u, wr, wc, fr, fq, lds, wid, lane) || poison != 0u;
        const float qnan = __builtin_nanf("");
#pragma unroll
        for (int ai = 0; ai < 2; ++ai)
#pragma unroll
            for (int m = 0; m < 4; ++m) { const int r = ai * HALF + wr * 64 + m * 16 + fr; const f32x2v sr = S[r]; const size_t off = (size_t)(u.pm * BM + r) * ldc + col0;
#pragma unroll
                for (int bj = 0; bj < 2; ++bj)
#pragma unroll
                    for (int n = 0; n < 2; ++n) { const f32x4 bs = ai == 0 ? pre[m][bj][n] : *(const f32x4*)(base + off + bj * HALF + n * 16); f32x4 o = bs + (acc[ai][bj][m][n] - sr.x) * sr.y;
                        if (bad) o = (f32x4){qnan, qnan, qnan, qnan}; *(f32x4*)(out + off + bj * HALF + n * 16) = o; }
                if (m & 1) asm volatile("" ::: "memory"); }
    }
};
struct EpiLnResLn {
    static constexpr bool PERM = false, AFTER_DRAIN = true;
    const float* base; float* out; bf16_t* xn; int ldc; const float* bias; PanelStats st1, st2; unsigned poison;
    __device__ __forceinline__ void fused(f32x4 (&acc)[2][2][4][2], const Unit& u, int wr, int wc, int fr, int fq, PG8_LAS unsigned char* lds, int wid, int lane) const {
        typedef float f32x2v __attribute__((ext_vector_type(2))); typedef unsigned u32x2v __attribute__((ext_vector_type(2)));
        const PG8_LAS f32x2v* S = (const PG8_LAS f32x2v*)(lds + 8192);
        const int col0 = u.pn * BM + wc * 32 + 4 * fq;
#pragma unroll
        for (int bj = 0; bj < 2; ++bj)
#pragma unroll
            for (int n = 0; n < 2; ++n) { const f32x4 bv = bias ? *(const f32x4*)(bias + col0 + bj * HALF + n * 16) : (f32x4){0.f, 0.f, 0.f, 0.f};
#pragma unroll
                for (int ai = 0; ai < 2; ++ai)
#pragma unroll
                    for (int m = 0; m < 4; ++m) acc[ai][bj][m][n] += bv; }
        bool bad = st1.run(acc, u, wr, wc, fr, fq, lds, wid, lane) || poison != 0u;
        const float qnan = __builtin_nanf("");
#pragma unroll
        for (int ai = 0; ai < 2; ++ai)
#pragma unroll
            for (int m = 0; m < 4; ++m) { const int r = ai * HALF + wr * 64 + m * 16 + fr; const f32x2v sr = S[r]; const size_t off = (size_t)(u.pm * BM + r) * ldc + col0;
#pragma unroll
                for (int bj = 0; bj < 2; ++bj)
#pragma unroll
                    for (int n = 0; n < 2; ++n) { const f32x4 bs = *(const f32x4*)(base + off + bj * HALF + n * 16); acc[ai][bj][m][n] = bs + (acc[ai][bj][m][n] - sr.x) * sr.y; }
                asm volatile("" : "+v"(acc[ai][0][m][0]), "+v"(acc[ai][0][m][1]), "+v"(acc[ai][1][m][0]), "+v"(acc[ai][1][m][1]));
                if (m & 1) asm volatile("" ::: "memory"); }
        const bool bad1 = bad;
        bad = st2.run(acc, u, wr, wc, fr, fq, lds, wid, lane) || bad;
#pragma unroll
        for (int ai = 0; ai < 2; ++ai)
#pragma unroll
            for (int m = 0; m < 4; ++m) { const int r = ai * HALF + wr * 64 + m * 16 + fr; const f32x2v sr = S[r]; const size_t off = (size_t)(u.pm * BM + r) * ldc + col0;
#pragma unroll
                for (int bj = 0; bj < 2; ++bj)
#pragma unroll
                    for (int n = 0; n < 2; ++n) { const f32x4 x1 = acc[ai][bj][m][n]; *(f32x4*)(out + off + bj * HALF + n * 16) = bad1 ? (f32x4){qnan, qnan, qnan, qnan} : x1;
                        const f32x4 o = (x1 - sr.x) * sr.y; u32x2v w; w.x = cvt_pk_bf16(o[0], o[1]); w.y = cvt_pk_bf16(o[2], o[3]);
                        if (bad) { w.x = 0x7fc07fc0u; w.y = 0x7fc07fc0u; } *(u32x2v*)(xn + off + bj * HALF + n * 16) = w; }
                asm volatile("" ::: "memory"); }
    }
};

template <class Epi, class Sched, bool ALIGN_EPI = false, bool SP2 = false>
__device__ __forceinline__ void gemm_phase(PG8_LAS unsigned char* lds, const Gemm g, const Sched& S, const Epi& E) {
    const int tid = threadIdx.x, wid = __builtin_amdgcn_readfirstlane(tid >> 6), lane = tid & 63, wr = wid >> 2, wc = wid & 3, fr = lane & 15, fq = lane >> 4;
    const int K = g.K, nt = K / BK;
    unsigned voffA[2], voffB[2];
#pragma unroll
    for (int i = 0; i < 2; ++i) { int R, C; stage_rc(tid * 16 + i * 8192, R, C); const int Rb = Epi::PERM ? ((R & ~31) + perm32(R & 31)) : R;
        voffA[i] = (unsigned)(R * K + C) * 2u; voffB[i] = (unsigned)(Rb * K + C) * 2u; }
    const size_t kstep = (size_t)(BK * 2);
    const size_t hstep = (size_t)HALF * K * 2;
    const size_t tstep = 2 * hstep;
    const unsigned ldsw = (unsigned)wid * 1024u;
    const int aoff = lds_byte(wr * 64 + fr, fq * 8), boff = lds_byte(wc * 32 + fr, fq * 8);
#define PG8_SA(b, h) (((b) * 2 + (h)) * HTB)
#define PG8_SB(b, h) ((4 + (b) * 2 + (h)) * HTB)
#define PG8_STAGE(bufoff, gbase, voff) do { _Pragma("unroll") for (int _i = 0; _i < 2; ++_i) \
        __builtin_amdgcn_global_load_lds((const unsigned*)((const char*)(gbase) + (voff)[_i]), (PG8_LAS unsigned*)(lds + (bufoff) + ldsw + _i * 8192), 16, 0, 0); } while (0)
#define PG8_LDA(dst, b, h) do { _Pragma("unroll") for (int m = 0; m < 4; ++m) _Pragma("unroll") for (int k = 0; k < 2; ++k) dst[m][k] = *(const PG8_LAS bf16x8*)(lds + PG8_SA(b, h) + aoff + m * 2048 + k * 1024); } while (0)
#define PG8_LDB(dst, b, h) do { _Pragma("unroll") for (int n = 0; n < 2; ++n) _Pragma("unroll") for (int k = 0; k < 2; ++k) dst[n][k] = *(const PG8_LAS bf16x8*)(lds + PG8_SB(b, h) + boff + n * 2048 + k * 1024); } while (0)
#define PG8_MMA(ai, bj, At, Bt) do { __builtin_amdgcn_s_setprio(1); _Pragma("unroll") for (int m = 0; m < 4; ++m) _Pragma("unroll") for (int n = 0; n < 2; ++n) _Pragma("unroll") for (int k = 0; k < 2; ++k) \
        acc[ai][bj][m][n] = __builtin_amdgcn_mfma_f32_16x16x32_bf16(Bt[n][k], At[m][k], acc[ai][bj][m][n], 0, 0, 0); __builtin_amdgcn_s_setprio(0); } while (0)
#define PG8_WAIT_V(n) asm volatile("s_waitcnt vmcnt(" #n ")" ::: "memory")
#define PG8_WAIT_L(n) asm volatile("s_waitcnt lgkmcnt(" #n ")" ::: "memory")
#define PG8_BAR __builtin_amdgcn_s_barrier()
#define PG8_SCHED __builtin_amdgcn_sched_barrier(0)
    Unit cur, nxt; int ui = 0;
    if (!S.next(0, cur)) return;
    f32x4 acc[2][2][4][2];
#pragma unroll
    for (int a = 0; a < 2; ++a)
#pragma unroll
        for (int b = 0; b < 2; ++b)
#pragma unroll
            for (int m = 0; m < 4; ++m)
#pragma unroll
                for (int n = 0; n < 2; ++n) acc[a][b][m][n] = (f32x4){0.f, 0.f, 0.f, 0.f};
    bf16x8 At[4][2], B0[2][2], B1[2][2];
    const char* cA = (const char*)g.A + (size_t)cur.pm * tstep; const char* cB = (const char*)g.Bt + (size_t)cur.pn * tstep;
    S.a_ready(cur);
    if constexpr (SP2) {
        PG8_STAGE(PG8_SB(0, 0), cB, voffB); PG8_STAGE(PG8_SB(0, 1), cB + hstep, voffB); PG8_STAGE(PG8_SA(0, 0), cA, voffA); PG8_STAGE(PG8_SA(0, 1), cA + hstep, voffA);
        if (wr == 1) PG8_BAR;
        PG8_WAIT_V(2); PG8_BAR;
        PG8_STAGE(PG8_SB(1, 0), cB + kstep, voffB); PG8_STAGE(PG8_SA(1, 0), cA + kstep, voffA); PG8_STAGE(PG8_SB(1, 1), cB + hstep + kstep, voffB);
        PG8_WAIT_V(6); PG8_BAR;
    } else {
        PG8_STAGE(PG8_SB(0, 0), cB, voffB); PG8_STAGE(PG8_SA(0, 0), cA, voffA); PG8_STAGE(PG8_SB(0, 1), cB + hstep, voffB); PG8_STAGE(PG8_SA(0, 1), cA + hstep, voffA);
        if (wr == 1) PG8_BAR;
        PG8_WAIT_V(4); PG8_BAR;
        PG8_STAGE(PG8_SB(1, 0), cB + kstep, voffB); PG8_STAGE(PG8_SA(1, 0), cA + kstep, voffA); PG8_STAGE(PG8_SB(1, 1), cB + hstep + kstep, voffB);
        PG8_WAIT_V(6); PG8_BAR;
    }
    for (;;) {
        const bool has_next = S.next(ui + 1, nxt);
        const char* nA = has_next ? (const char*)g.A + (size_t)nxt.pm * tstep : cA; const char* nB = has_next ? (const char*)g.Bt + (size_t)nxt.pn * tstep : cB;
        for (int t = 0; t < nt; t += 2) {
            const bool last = (t == nt - 2);
            const char* a1 = cA + (size_t)(t + 1) * kstep;
            const char* a2 = last ? nA : cA + (size_t)(t + 2) * kstep; const char* b2 = last ? nB : cB + (size_t)(t + 2) * kstep;
            const char* a3 = a2 + kstep; const char* b3 = b2 + kstep;
            if (last && has_next) S.a_ready(nxt);
            if constexpr (SP2) {
            PG8_LDB(B0, 0, 0); PG8_LDB(B1, 0, 1); PG8_SCHED; PG8_LDA(At, 0, 0); PG8_STAGE(PG8_SA(1, 1), a1 + hstep, voffA);
            PG8_WAIT_V(8); PG8_WAIT_L(0); PG8_BAR; PG8_MMA(0, 0, At, B0); PG8_MMA(0, 1, At, B1); PG8_BAR; PG8_SCHED;
            PG8_LDA(At, 0, 1); PG8_STAGE(PG8_SB(0, 0), b2, voffB); PG8_STAGE(PG8_SB(0, 1), b2 + hstep, voffB); PG8_STAGE(PG8_SA(0, 0), a2, voffA);
            PG8_WAIT_V(8); PG8_WAIT_L(0); PG8_BAR; PG8_MMA(1, 0, At, B0); PG8_MMA(1, 1, At, B1); PG8_BAR; PG8_SCHED;
            PG8_LDB(B0, 1, 0); PG8_LDB(B1, 1, 1); PG8_SCHED; PG8_LDA(At, 1, 0); PG8_STAGE(PG8_SA(0, 1), a2 + hstep, voffA);
            PG8_WAIT_V(8); PG8_WAIT_L(0); PG8_BAR; PG8_MMA(0, 0, At, B0); PG8_MMA(0, 1, At, B1); PG8_BAR; PG8_SCHED;
            PG8_LDA(At, 1, 1); PG8_STAGE(PG8_SB(1, 0), b3, voffB); PG8_STAGE(PG8_SB(1, 1), b3 + hstep, voffB); PG8_STAGE(PG8_SA(1, 0), a3, voffA);
            PG8_WAIT_V(8); PG8_WAIT_L(0); PG8_BAR; PG8_MMA(1, 0, At, B0); PG8_MMA(1, 1, At, B1); PG8_BAR; PG8_SCHED;
            } else {
            PG8_LDB(B0, 0, 0); PG8_SCHED; PG8_LDA(At, 0, 0); PG8_STAGE(PG8_SA(1, 1), a1 + hstep, voffA);
            PG8_WAIT_L(8); PG8_BAR; PG8_WAIT_L(0); PG8_MMA(0, 0, At, B0); PG8_BAR; PG8_SCHED;
            PG8_LDB(B1, 0, 1); PG8_STAGE(PG8_SB(0, 0), b2, voffB);
            PG8_BAR; PG8_WAIT_L(0); PG8_MMA(0, 1, At, B1); PG8_BAR;
            PG8_LDA(At, 0, 1); PG8_STAGE(PG8_SA(0, 0), a2, voffA);
            PG8_BAR; PG8_WAIT_L(0); PG8_MMA(1, 0, At, B0); PG8_BAR; PG8_SCHED;
            PG8_STAGE(PG8_SB(0, 1), b2 + hstep, voffB);
            PG8_WAIT_V(6); PG8_BAR; PG8_MMA(1, 1, At, B1); PG8_BAR;
            PG8_LDB(B0, 1, 0); PG8_SCHED; PG8_LDA(At, 1, 0); PG8_STAGE(PG8_SA(0, 1), a2 + hstep, voffA);
            PG8_WAIT_L(8); PG8_BAR; PG8_WAIT_L(0); PG8_MMA(0, 0, At, B0); PG8_BAR; PG8_SCHED;
            PG8_LDB(B1, 1, 1); PG8_STAGE(PG8_SB(1, 0), b3, voffB);
            PG8_BAR; PG8_WAIT_L(0); PG8_MMA(0, 1, At, B1); PG8_BAR;
            PG8_LDA(At, 1, 1); PG8_STAGE(PG8_SA(1, 0), a3, voffA);
            PG8_BAR; PG8_WAIT_L(0); PG8_MMA(1, 0, At, B0); PG8_BAR; PG8_SCHED;
            PG8_STAGE(PG8_SB(1, 1), b3 + hstep, voffB);
            PG8_WAIT_V(6); PG8_BAR; PG8_MMA(1, 1, At, B1); PG8_BAR;
            }
        }
        if constexpr (ALIGN_EPI) { if (wr == 0) PG8_BAR; }
        if constexpr (!Epi::AFTER_DRAIN) { E(acc, cur, wr, wc, fr, fq); S.done(cur); }
        if (!has_next) break;
#pragma unroll
        for (int a = 0; a < 2; ++a)
#pragma unroll
            for (int b = 0; b < 2; ++b)
#pragma unroll
                for (int m = 0; m < 4; ++m)
#pragma unroll
                    for (int n = 0; n < 2; ++n) acc[a][b][m][n] = (f32x4){0.f, 0.f, 0.f, 0.f};
        cur = nxt; cA = nA; cB = nB; ++ui;
        if constexpr (ALIGN_EPI) { if (wr == 1) PG8_BAR; }
    }
    PG8_WAIT_V(0);
    if constexpr (!ALIGN_EPI) { if (wr == 0) PG8_BAR; }
    PG8_BAR;
    if constexpr (Epi::AFTER_DRAIN) { E.fused(acc, cur, wr, wc, fr, fq, lds, wid, lane); S.done(cur); }
#undef PG8_SA
#undef PG8_SB
#undef PG8_STAGE
#undef PG8_LDA
#undef PG8_LDB
#undef PG8_MMA
#undef PG8_WAIT_V
#undef PG8_WAIT_L
#undef PG8_BAR
#undef PG8_SCHED
}
}

namespace pg8 {
__device__ __forceinline__ float silu_f(float x) { return x * __builtin_amdgcn_rcpf(1.0f + __expf(-x)); }
__device__ __forceinline__ float sigm_f(float x) { return __builtin_amdgcn_rcpf(1.0f + __expf(-x)); }
__device__ __forceinline__ float bfu2f(unsigned short u) { return __uint_as_float((unsigned)u << 16); }
struct EpiSwiGLU {
    static constexpr bool PERM = true, AFTER_DRAIN = false;
    bf16_t* H; int ldh;
    __device__ __forceinline__ void operator()(const f32x4 (&acc)[2][2][4][2], const Unit& u, int wr, int wc, int fr, int fq) const {
        const int row0 = u.pm * BM + wr * 64 + fr, col0 = u.pn * HALF + wc * 32 + 8 * fq;
#pragma unroll
        for (int ai = 0; ai < 2; ++ai)
#pragma unroll
            for (int m = 0; m < 4; ++m) {
                bf16_t* rowp = H + (size_t)(row0 + ai * HALF + m * 16) * ldh + col0;
                const f32x4 g0 = acc[ai][0][m][0], g1 = acc[ai][0][m][1], u0 = acc[ai][1][m][0], u1 = acc[ai][1][m][1];
                u32x4 w;
                w.x = cvt_pk_bf16(silu_f(g0[0]) * u0[0], silu_f(g0[1]) * u0[1]); w.y = cvt_pk_bf16(silu_f(g0[2]) * u0[2], silu_f(g0[3]) * u0[3]);
                w.z = cvt_pk_bf16(silu_f(g1[0]) * u1[0], silu_f(g1[1]) * u1[1]); w.w = cvt_pk_bf16(silu_f(g1[2]) * u1[2], silu_f(g1[3]) * u1[3]);
                *(u32x4*)rowp = w;
            }
    }
};
template <bool GATE> struct EpiResid {
    static constexpr bool PERM = true, AFTER_DRAIN = false;
    const float* res; float* out; const bf16_t* PP; float alpha, s;
    __device__ __forceinline__ void operator()(const f32x4 (&acc)[2][2][4][2], const Unit& u, int wr, int wc, int fr, int fq) const {
        const int row0 = u.pm * BM + wr * 64 + fr, col0 = u.pn * BM + wc * 32 + 8 * fq;
#pragma unroll
        for (int ai = 0; ai < 2; ++ai)
#pragma unroll
            for (int m = 0; m < 4; ++m) {
                const size_t off = (size_t)(row0 + ai * HALF + m * 16) * 1024 + col0;
#pragma unroll
                for (int bj = 0; bj < 2; ++bj) {
                    const f32x4 r0 = *(const f32x4*)(res + off + bj * HALF), r1 = *(const f32x4*)(res + off + bj * HALF + 4);
                    f32x4 a0 = acc[ai][bj][m][0], a1 = acc[ai][bj][m][1];
                    if (GATE) {
                        const u32x4 pw = *(const u32x4*)(PP + off + bj * HALF);
                        a0[0] = sigm_f(a0[0]) * __uint_as_float(pw.x << 16); a0[1] = sigm_f(a0[1]) * __uint_as_float(pw.x & 0xffff0000u);
                        a0[2] = sigm_f(a0[2]) * __uint_as_float(pw.y << 16); a0[3] = sigm_f(a0[3]) * __uint_as_float(pw.y & 0xffff0000u);
                        a1[0] = sigm_f(a1[0]) * __uint_as_float(pw.z << 16); a1[1] = sigm_f(a1[1]) * __uint_as_float(pw.z & 0xffff0000u);
                        a1[2] = sigm_f(a1[2]) * __uint_as_float(pw.w << 16); a1[3] = sigm_f(a1[3]) * __uint_as_float(pw.w & 0xffff0000u);
                    }
                    *(f32x4*)(out + off + bj * HALF) = r0 * alpha + a0 * s; *(f32x4*)(out + off + bj * HALF + 4) = r1 * alpha + a1 * s;
                }
            }
    }
};
}

#include <hip/hip_cooperative_groups.h>
namespace cg = cooperative_groups;
constexpr int NWAVES = 8;
constexpr int BATCH = 16, SEQ = 2048, D = 1024, FF = 2816, FF2 = 2 * FF, PLE = 256, NC = SEQ / 64;
constexpr int M = BATCH * SEQ;
constexpr int MIXN = 3592, MIXP = 3840;
constexpr int UQ = 0, UF = 512, UV = 1024, UG = 1536, UZ = 2048, UX = 2560, UDT = 3584;
constexpr float ALPHA = 1.189207115002721f, LN_EPS = 1e-5f, RMS_EPS = 1e-6f;
constexpr size_t MiB = 1u << 20;
constexpr size_t WS_W1IN = 1 * MiB, WS_W1OUT = 12 * MiB, WS_WMIX = 18 * MiB, WS_WOUT = 26 * MiB, WS_W2IN = 28 * MiB, WS_W2OUT = 39 * MiB, WS_WGATE = 45 * MiB, WS_WPROJ = 47 * MiB;
constexpr size_t WS_SS = 48 * MiB, WS_XB = 50 * MiB, WS_PB = 114 * MiB, WS_BIG = 130 * MiB, WS_END = 370 * MiB;
constexpr int LDS_BYTES = 135168;

#define LAS __attribute__((address_space(3)))
typedef unsigned short bf16;
typedef float f32x4 __attribute__((ext_vector_type(4)));
typedef short bf16x8 __attribute__((ext_vector_type(8)));
typedef unsigned v4u __attribute__((ext_vector_type(4)));
typedef unsigned v2u __attribute__((ext_vector_type(2)));
__device__ __forceinline__ unsigned f2bf(float f) { unsigned u = __builtin_bit_cast(unsigned, f); return (u + 0x7fffu + ((u >> 16) & 1u)) >> 16; }
__device__ __forceinline__ unsigned pk2(float lo, float hi) { return f2bf(lo) | (f2bf(hi) << 16); }
__device__ __forceinline__ float bf2f(unsigned short u) { return __uint_as_float((unsigned)u << 16); }
__device__ __forceinline__ float silu(float x) { return x * __builtin_amdgcn_rcpf(1.0f + __expf(-x)); }
__device__ __forceinline__ float wave_sum(float v) {
#pragma unroll
    for (int o = 1; o < 64; o <<= 1) v += __shfl_xor(v, o);
    return v;
}
#define MFMA16(a, b, c) __builtin_amdgcn_mfma_f32_16x16x32_bf16((a), (b), (c), 0, 0, 0)

struct Args { const float* in[26]; float* out; unsigned char* ws; int ph_lo, ph_hi; };

__device__ __forceinline__ void tr_item(const float* W, int K, int N, bf16* WT, int k0, int n0, int drow0, LAS float* scr, int lane) {
    const int nn = n0 + (lane & 31);
#pragma unroll 8
    for (int i = 0; i < 32; ++i) { const int kk = 2 * i + (lane >> 5); scr[kk * 33 + (lane & 31)] = (nn < N) ? W[(size_t)(k0 + kk) * N + nn] : 0.f; }
    asm volatile("s_waitcnt lgkmcnt(0)" ::: "memory");
    const int c = lane & 7;
#pragma unroll
    for (int j = 0; j < 4; ++j) { const int n = (lane >> 3) + 8 * j; const LAS float* s = scr + (8 * c) * 33 + n;
        v4u o; o.x = pk2(s[0 * 33], s[1 * 33]); o.y = pk2(s[2 * 33], s[3 * 33]); o.z = pk2(s[4 * 33], s[5 * 33]); o.w = pk2(s[6 * 33], s[7 * 33]);
        *(v4u*)(WT + (size_t)(drow0 + n) * K + k0 + 8 * c) = o; }
    asm volatile("s_waitcnt lgkmcnt(0)" ::: "memory");
}
__device__ __forceinline__ int swiglu_drow(int n0) { return n0 < FF ? 256 * (n0 / 128) + (n0 % 128) : 256 * ((n0 - FF) / 128) + 128 + ((n0 - FF) % 128); }

__device__ __forceinline__ void prologue(const Args& a, LAS unsigned char* lds, int gw, int NGW, int wave, int lane) {
    LAS float* scr = (LAS float*)(lds + wave * 16384);
    unsigned char* ws = a.ws;
    constexpr int I1 = (D / 64) * (FF2 / 32), I2 = (FF / 64) * (D / 32), I3 = (D / 64) * (MIXP / 32), I4 = (D / 64) * (D / 32), I8 = (PLE / 64) * (D / 32);
    constexpr int NIT = 2 * I1 + 2 * I2 + I3 + 2 * I4 + I8;
    for (int it = gw; it < NIT; it += NGW) {
        int r = it;
        if (r < 2 * I1) { const int which = r / I1; r %= I1; const int nb = r % (FF2 / 32), kb = r / (FF2 / 32);
            tr_item(a.in[which ? 18 : 2], D, FF2, (bf16*)(ws + (which ? WS_W2IN : WS_W1IN)), 64 * kb, 32 * nb, swiglu_drow(32 * nb), scr, lane); continue; }
        r -= 2 * I1;
        if (r < 2 * I2) { const int which = r / I2; r %= I2; const int nb = r % (D / 32), kb = r / (D / 32);
            tr_item(a.in[which ? 19 : 3], FF, D, (bf16*)(ws + (which ? WS_W2OUT : WS_W1OUT)), 64 * kb, 32 * nb, 32 * nb, scr, lane); continue; }
        r -= 2 * I2;
        if (r < I3) { const int nb = r % (MIXP / 32), kb = r / (MIXP / 32);
            tr_item(a.in[6], D, MIXN, (bf16*)(ws + WS_WMIX), 64 * kb, 32 * nb, 32 * nb, scr, lane); continue; }
        r -= I3;
        if (r < 2 * I4) { const int which = r / I4; r %= I4; const int nb = r % (D / 32), kb = r / (D / 32);
            tr_item(a.in[which ? 23 : 15], D, D, (bf16*)(ws + (which ? WS_WGATE : WS_WOUT)), 64 * kb, 32 * nb, 32 * nb, scr, lane); continue; }
        r -= 2 * I4;
        { const int nb = r % (D / 32), kb = r / (D / 32);
            tr_item(a.in[22], PLE, D, (bf16*)(ws + WS_WPROJ), 64 * kb, 32 * nb, 32 * nb, scr, lane); }
    }
    const float* x = a.in[0]; bf16* XB = (bf16*)(ws + WS_XB);
    for (int m = gw; m < M; m += NGW) {
        const f32x4* xr = (const f32x4*)(x + (size_t)m * D) + lane; v2u* o = (v2u*)(XB + (size_t)m * D) + lane;
#pragma unroll
        for (int j = 0; j < 4; ++j) { const f32x4 v = xr[64 * j]; v2u w; w.x = pk2(v.x, v.y); w.y = pk2(v.z, v.w); o[64 * j] = w; }
    }
    const float* p = a.in[1]; bf16* PB = (bf16*)(ws + WS_PB);
    for (int m = gw; m < M; m += NGW) {
        const f32x4 v = *((const f32x4*)(p + (size_t)m * PLE) + lane); v2u w; w.x = pk2(v.x, v.y); w.y = pk2(v.z, v.w); *((v2u*)(PB + (size_t)m * PLE) + lane) = w;
    }
}

__device__ __forceinline__ void ln_pass(float* X, const float* g, const float* b, bf16* XB, int gw, int NGW, int lane) {
    f32x4 gv[4], bv[4];
#pragma unroll
    for (int j = 0; j < 4; ++j) { gv[j] = *((const f32x4*)g + lane + 64 * j); bv[j] = *((const f32x4*)b + lane + 64 * j); }
    for (int m = gw; m < M; m += NGW) {
        f32x4* xr = (f32x4*)(X + (size_t)m * D) + lane;
        f32x4 v[4]; float s = 0.f;
#pragma unroll
        for (int j = 0; j < 4; ++j) { v[j] = xr[64 * j]; s += (v[j].x + v[j].y) + (v[j].z + v[j].w); }
        const float mean = wave_sum(s) * (1.f / D); float s2 = 0.f;
#pragma unroll
        for (int j = 0; j < 4; ++j) { v[j] = v[j] - mean; s2 += (v[j].x * v[j].x + v[j].y * v[j].y) + (v[j].z * v[j].z + v[j].w * v[j].w); }
        const float rstd = 1.f / sqrtf(wave_sum(s2) * (1.f / D) + LN_EPS);
#pragma unroll
        for (int j = 0; j < 4; ++j) { v[j] = v[j] * rstd * gv[j] + bv[j]; xr[64 * j] = v[j]; }
        if (XB) { v2u* o = (v2u*)(XB + (size_t)m * D) + lane;
#pragma unroll
            for (int j = 0; j < 4; ++j) { v2u w; w.x = pk2(v[j].x, v[j].y); w.y = pk2(v[j].z, v[j].w); o[64 * j] = w; } }
    }
}

__device__ __forceinline__ void ssd_norm_pass(bf16* O, const float* SS, const float* ng, int gw, int NGW, int lane) {
    float gv[8];
#pragma unroll
    for (int j = 0; j < 8; ++j) gv[j] = ng[8 * lane + j];
    for (int m = gw; m < M; m += NGW) {
        float s = (lane < 16) ? SS[(size_t)m * 16 + lane] : 0.f;
        s = wave_sum(s);
        const float sc = 1.f / sqrtf(s * (1.f / 512.f) + RMS_EPS);
        v4u* pp = (v4u*)(O + (size_t)m * D + 512) + lane; v4u w = *pp;
        float f[8];
        f[0] = __uint_as_float(w.x << 16); f[1] = __uint_as_float(w.x & 0xffff0000u); f[2] = __uint_as_float(w.y << 16); f[3] = __uint_as_float(w.y & 0xffff0000u);
        f[4] = __uint_as_float(w.z << 16); f[5] = __uint_as_float(w.z & 0xffff0000u); f[6] = __uint_as_float(w.w << 16); f[7] = __uint_as_float(w.w & 0xffff0000u);
#pragma unroll
        for (int j = 0; j < 8; ++j) f[j] = f[j] * sc * gv[j];
        w.x = pk2(f[0], f[1]); w.y = pk2(f[2], f[3]); w.z = pk2(f[4], f[5]); w.w = pk2(f[6], f[7]);
        *pp = w;
    }
}

constexpr int QP = 136, TP = 72;
constexpr int H_QT = 0, H_KT = H_QT + 64 * QP * 2, H_KTT = H_KT + 64 * QP * 2, H_VT = H_KTT + 128 * TP * 2, H_P = H_VT + 128 * TP * 2, H_ST = H_P + 64 * TP * 2,
              H_DV = H_ST + 128 * QP * 2, H_TOT = H_DV + 512, H_RMS = H_TOT + 2048, H_END = H_RMS + 512;
static_assert(H_END <= 131072, "hgrn lds");
__device__ __forceinline__ void hgrn_item(const Args& a, LAS unsigned char* lds, int b, int h, int tid) {
    const int lane = tid & 63, w = __builtin_amdgcn_readfirstlane(tid >> 6), l15 = lane & 15, l4 = lane >> 4;
    LAS bf16* Qt = (LAS bf16*)(lds + H_QT); LAS bf16* Kt = (LAS bf16*)(lds + H_KT); LAS bf16* KtT = (LAS bf16*)(lds + H_KTT); LAS bf16* VT = (LAS bf16*)(lds + H_VT);
    LAS bf16* P = (LAS bf16*)(lds + H_P); LAS bf16* ST = (LAS bf16*)(lds + H_ST); LAS float* dvec = (LAS float*)(lds + H_DV); LAS float* tot = (LAS float*)(lds + H_TOT); LAS float* rmsx = (LAS float*)(lds + H_RMS);
    const bf16* U = (const bf16*)(a.ws + WS_BIG); bf16* O = (bf16*)(a.ws + WS_XB);
    const int ek = tid & 127, eq = tid >> 7;
    float lb; { const float l0 = a.in[7][h * 128 + ek], l1 = a.in[7][512 + h * 128 + ek]; lb = 1.f / (1.f + __expf(l1 - l0)); }
    const float* ngp = a.in[8];
    f32x4 S[8];
#pragma unroll
    for (int j = 0; j < 8; ++j) S[j] = (f32x4){0.f, 0.f, 0.f, 0.f};
    for (int i = tid; i < 128 * QP / 2; i += 512) ((LAS unsigned*)ST)[i] = 0u;
    __syncthreads();
    for (int c = 0; c < NC; ++c) {
        const int m0 = b * SEQ + 64 * c;
        const int ti = w >> 1, vj0 = 4 * (w & 1);
        unsigned short gr[4][4];
        {
            const bf16* Ur = U + (size_t)(m0 + 16 * eq) * MIXP + h * 128 + ek;
            unsigned short qr[16], fr[16], vr[16];
#pragma unroll
            for (int j = 0; j < 16; ++j) { qr[j] = Ur[(size_t)j * MIXP + UQ]; fr[j] = Ur[(size_t)j * MIXP + UF]; vr[j] = Ur[(size_t)j * MIXP + UV]; }
#pragma unroll
            for (int jj = 0; jj < 4; ++jj)
#pragma unroll
                for (int i = 0; i < 4; ++i) gr[jj][i] = U[(size_t)(m0 + 16 * ti + 4 * l4 + i) * MIXP + UG + h * 128 + 16 * (vj0 + jj) + l15];
            __builtin_amdgcn_sched_barrier(0);
            float bbl[16], fk[16]; float run = 0.f;
#pragma unroll
            for (int j = 0; j < 16; ++j) { const float f = lb + (1.f - lb) * __builtin_amdgcn_rcpf(1.f + __expf(-bf2f(fr[j]))); fk[j] = 1.f - f; run += __logf(f); bbl[j] = run; }
            tot[eq * 128 + ek] = run;
            __syncthreads();
            float off = 0.f, blast = 0.f;
#pragma unroll
            for (int q = 0; q < 4; ++q) { const float t = tot[q * 128 + ek]; blast += t; if (q < eq) off += t; }
            unsigned kp[8], vp[8];
#pragma unroll
            for (int j = 0; j < 16; j += 2) {
                const float b0 = bbl[j] + off, b1 = bbl[j + 1] + off;
                const unsigned q0 = f2bf(silu(bf2f(qr[j])) * __expf(b0)), q1 = f2bf(silu(bf2f(qr[j + 1])) * __expf(b1));
                const unsigned k0 = f2bf(fk[j] * __expf(-b0)), k1 = f2bf(fk[j + 1] * __expf(-b1));
                Qt[(16 * eq + j) * QP + ek] = (bf16)q0; Qt[(16 * eq + j + 1) * QP + ek] = (bf16)q1;
                Kt[(16 * eq + j) * QP + ek] = (bf16)k0; Kt[(16 * eq + j + 1) * QP + ek] = (bf16)k1;
                kp[j >> 1] = k0 | (k1 << 16); vp[j >> 1] = (unsigned)vr[j] | ((unsigned)vr[j + 1] << 16);
            }
            *(LAS v4u*)(KtT + ek * TP + 16 * eq) = (v4u){kp[0], kp[1], kp[2], kp[3]}; *(LAS v4u*)(KtT + ek * TP + 16 * eq + 8) = (v4u){kp[4], kp[5], kp[6], kp[7]};
            *(LAS v4u*)(VT + ek * TP + 16 * eq) = (v4u){vp[0], vp[1], vp[2], vp[3]}; *(LAS v4u*)(VT + ek * TP + 16 * eq + 8) = (v4u){vp[4], vp[5], vp[6], vp[7]};
            if (eq == 0) dvec[ek] = __expf(blast);
        }
        __syncthreads();
        {
            const int sj0 = 2 * (w & 1);
#pragma unroll
            for (int jj = 0; jj < 2; ++jj) {
                const int sj = sj0 + jj; f32x4 acc = (f32x4){0.f, 0.f, 0.f, 0.f};
                if (sj <= ti) {
#pragma unroll
                    for (int kk = 0; kk < 4; ++kk) { const bf16x8 af = *(const LAS bf16x8*)(Qt + (16 * ti + l15) * QP + 32 * kk + 8 * l4), bfr = *(const LAS bf16x8*)(Kt + (16 * sj + l15) * QP + 32 * kk + 8 * l4); acc = MFMA16(af, bfr, acc); }
                }
#pragma unroll
                for (int i = 0; i < 4; ++i) { const int t = 16 * ti + 4 * l4 + i, s = 16 * sj + l15; P[t * TP + s] = (bf16)f2bf(s <= t ? acc[i] : 0.f); }
            }
        }
        __syncthreads();
        {
            f32x4 o[4];
#pragma unroll
            for (int jj = 0; jj < 4; ++jj) {
                const int vj = vj0 + jj; f32x4 acc = (f32x4){0.f, 0.f, 0.f, 0.f};
#pragma unroll
                for (int kk = 0; kk < 2; ++kk) { const bf16x8 af = *(const LAS bf16x8*)(P + (16 * ti + l15) * TP + 32 * kk + 8 * l4), bfr = *(const LAS bf16x8*)(VT + (16 * vj + l15) * TP + 32 * kk + 8 * l4); acc = MFMA16(af, bfr, acc); }
#pragma unroll
                for (int kk = 0; kk < 4; ++kk) { const bf16x8 af = *(const LAS bf16x8*)(Qt + (16 * ti + l15) * QP + 32 * kk + 8 * l4), bfr = *(const LAS bf16x8*)(ST + (16 * vj + l15) * QP + 32 * kk + 8 * l4); acc = MFMA16(af, bfr, acc); }
                o[jj] = acc;
            }
            float ss[4];
#pragma unroll
            for (int i = 0; i < 4; ++i) { float s = 0.f;
#pragma unroll
                for (int jj = 0; jj < 4; ++jj) s += o[jj][i] * o[jj][i];
                s += __shfl_xor(s, 1); s += __shfl_xor(s, 2); s += __shfl_xor(s, 4); s += __shfl_xor(s, 8); ss[i] = s; }
            if (l15 == 0) {
#pragma unroll
                for (int i = 0; i < 4; ++i) rmsx[(w & 1) * 64 + 16 * ti + 4 * l4 + i] = ss[i];
            }
            __syncthreads();
#pragma unroll
            for (int i = 0; i < 4; ++i) { const int t = 16 * ti + 4 * l4 + i; const float tot2 = rmsx[t] + rmsx[64 + t]; const float rstd = 1.f / sqrtf(tot2 * (1.f / 128.f) + RMS_EPS);
#pragma unroll
                for (int jj = 0; jj < 4; ++jj) { const int v = 16 * (vj0 + jj) + l15; const float val = o[jj][i] * rstd * ngp[v] * silu(bf2f(gr[jj][i]));
                    O[(size_t)(m0 + t) * D + h * 128 + v] = (bf16)f2bf(val); } }
        }
        {
#pragma unroll
            for (int vj = 0; vj < 8; ++vj) {
#pragma unroll
                for (int kk = 0; kk < 2; ++kk) { const bf16x8 af = *(const LAS bf16x8*)(KtT + (16 * w + l15) * TP + 32 * kk + 8 * l4), bfr = *(const LAS bf16x8*)(VT + (16 * vj + l15) * TP + 32 * kk + 8 * l4); S[vj] = MFMA16(af, bfr, S[vj]); }
            }
            const f32x4 dv = *(const LAS f32x4*)(dvec + 16 * w + 4 * l4);
#pragma unroll
            for (int vj = 0; vj < 8; ++vj) { S[vj] = S[vj] * dv; v2u pk; pk.x = pk2(S[vj][0], S[vj][1]); pk.y = pk2(S[vj][2], S[vj][3]); *(LAS v2u*)(ST + (16 * vj + l15) * QP + 16 * w + 4 * l4) = pk; }
        }
    }
    __syncthreads();
}

constexpr int S_CQ = 0, S_BK = S_CQ + 64 * QP * 2, S_BT = S_BK + 64 * QP * 2, S_XT = S_BT + 128 * TP * 2, S_XS = S_XT + 64 * TP * 2, S_G = S_XS + 64 * TP * 2, S_HB = S_G + 64 * TP * 2,
              S_AC = S_HB + 64 * QP * 2, S_DT = S_AC + 256, S_END = S_DT + 256;
static_assert(S_END <= 131072, "ssd lds");
__device__ __forceinline__ void ssd_item(const Args& a, LAS unsigned char* lds, int b, int hd, int tid) {
    const int lane = tid & 63, w = __builtin_amdgcn_readfirstlane(tid >> 6), l15 = lane & 15, l4 = lane >> 4, g = hd >> 2;
    LAS bf16* Cq = (LAS bf16*)(lds + S_CQ); LAS bf16* Bk = (LAS bf16*)(lds + S_BK); LAS bf16* BT = (LAS bf16*)(lds + S_BT); LAS bf16* XT = (LAS bf16*)(lds + S_XT);
    LAS bf16* XS = (LAS bf16*)(lds + S_XS); LAS bf16* G = (LAS bf16*)(lds + S_G); LAS bf16* Hb = (LAS bf16*)(lds + S_HB); LAS float* acum = (LAS float*)(lds + S_AC); LAS float* dtv = (LAS float*)(lds + S_DT);
    const bf16* U = (const bf16*)(a.ws + WS_BIG); bf16* O = (bf16*)(a.ws + WS_XB); float* SS = (float*)(a.ws + WS_SS);
    const float* cw = a.in[9]; const float* cbias = a.in[10];
    const int ch = tid & 255, half = tid >> 8, isC = (ch >> 7), n = ch & 127;
    const int cbc = 512 + isC * 256 + g * 128 + n;
    const float w0 = cw[cbc], w1 = cw[1024 + cbc], w2 = cw[2048 + cbc], w3 = cw[3072 + cbc], wb = cbias[cbc];
    const int cx = hd * 64 + lane;
    const float x0w = cw[cx], x1w = cw[1024 + cx], x2w = cw[2048 + cx], x3w = cw[3072 + cx], xb = cbias[cx];
    const float Aneg = -__expf(a.in[12][hd]), dtb = a.in[11][hd], Dsk = a.in[13][hd];
    f32x4 Hs[4];
#pragma unroll
    for (int j = 0; j < 4; ++j) Hs[j] = (f32x4){0.f, 0.f, 0.f, 0.f};
    for (int i = tid; i < 64 * QP / 2; i += 512) ((LAS unsigned*)Hb)[i] = 0u;
    __syncthreads();
    for (int c = 0; c < NC; ++c) {
        const int m0 = b * SEQ + 64 * c;
        const int ti = w >> 1, pj0 = 2 * (w & 1);
        unsigned short zr[2][4], cr[35], xr[11], dtr;
        {
            dtr = U[(size_t)(m0 + lane) * MIXP + UDT + hd];
            const bf16* Uc = U + (size_t)(m0 + 32 * half) * MIXP + UX + cbc;
            const bool first = (c == 0 && half == 0);
#pragma unroll
            for (int j = 0; j < 35; ++j) cr[j] = (first && j < 3) ? (unsigned short)0 : Uc[((ptrdiff_t)j - 3) * (ptrdiff_t)MIXP];
            const bf16* Ux = U + (size_t)(m0 + 8 * w) * MIXP + UX + cx;
            const bool firstx = (c == 0 && w == 0);
#pragma unroll
            for (int j = 0; j < 11; ++j) xr[j] = (firstx && j < 3) ? (unsigned short)0 : Ux[((ptrdiff_t)j - 3) * (ptrdiff_t)MIXP];
#pragma unroll
            for (int jj = 0; jj < 2; ++jj)
#pragma unroll
                for (int i = 0; i < 4; ++i) zr[jj][i] = U[(size_t)(m0 + 16 * ti + 4 * l4 + i) * MIXP + UZ + hd * 64 + 16 * (pj0 + jj) + l15];
            __builtin_amdgcn_sched_barrier(0);
        }
        float dt, ac, wdec;
        {
            const float dr = bf2f(dtr) + dtb;
            dt = dr > 20.f ? dr : __logf(1.f + __expf(dr));
            ac = Aneg * dt;
#pragma unroll
            for (int o = 1; o < 64; o <<= 1) { const float t = __shfl_up(ac, o); if (lane >= o) ac += t; }
            const float aclast = __shfl(ac, 63);
            wdec = dt * __expf(aclast - ac);
            if (w == 0) { acum[lane] = ac; dtv[lane] = dt; }
        }
        {
            const int t0 = 32 * half;
            float xm3 = bf2f(cr[0]), xm2 = bf2f(cr[1]), xm1 = bf2f(cr[2]);
            LAS bf16* dst = isC ? Cq : Bk;
#pragma unroll
            for (int j8 = 0; j8 < 4; ++j8) {
                unsigned pk[4];
#pragma unroll
                for (int j = 0; j < 8; ++j) {
                    const float xc = bf2f(cr[3 + 8 * j8 + j]);
                    const float o = silu(wb + w0 * xm3 + w1 * xm2 + w2 * xm1 + w3 * xc);
                    xm3 = xm2; xm2 = xm1; xm1 = xc;
                    const unsigned ob = f2bf(o);
                    dst[(t0 + 8 * j8 + j) * QP + n] = (bf16)ob;
                    if (j & 1) pk[j >> 1] |= ob << 16; else pk[j >> 1] = ob;
                }
                if (!isC) *(LAS v4u*)(BT + n * TP + t0 + 8 * j8) = (v4u){pk[0], pk[1], pk[2], pk[3]};
            }
        }
        {
            const int t0 = 8 * w;
            float xm3 = bf2f(xr[0]), xm2 = bf2f(xr[1]), xm1 = bf2f(xr[2]);
            unsigned pk[4], ps[4];
#pragma unroll
            for (int j = 0; j < 8; ++j) {
                const float xc = bf2f(xr[3 + j]);
                const float o = silu(xb + x0w * xm3 + x1w * xm2 + x2w * xm1 + x3w * xc);
                xm3 = xm2; xm2 = xm1; xm1 = xc;
                const float wt = __shfl(wdec, t0 + j);
                const unsigned ob = f2bf(o), os = f2bf(o * wt);
                if (j & 1) { pk[j >> 1] |= ob << 16; ps[j >> 1] |= os << 16; } else { pk[j >> 1] = ob; ps[j >> 1] = os; }
            }
            *(LAS v4u*)(XT + lane * TP + t0) = (v4u){pk[0], pk[1], pk[2], pk[3]};
            *(LAS v4u*)(XS + lane * TP + t0) = (v4u){ps[0], ps[1], ps[2], ps[3]};
        }
        __syncthreads();
        {
            const int sj0 = 2 * (w & 1);
#pragma unroll
            for (int jj = 0; jj < 2; ++jj) {
                const int sj = sj0 + jj; f32x4 acc = (f32x4){0.f, 0.f, 0.f, 0.f};
                if (sj <= ti) {
#pragma unroll
                    for (int kk = 0; kk < 4; ++kk) { const bf16x8 af = *(const LAS bf16x8*)(Cq + (16 * ti + l15) * QP + 32 * kk + 8 * l4), bfr = *(const LAS bf16x8*)(Bk + (16 * sj + l15) * QP + 32 * kk + 8 * l4); acc = MFMA16(af, bfr, acc); }
                }
                const int s = 16 * sj + l15; const float as = acum[s], ds = dtv[s];
#pragma unroll
                for (int i = 0; i < 4; ++i) { const int t = 16 * ti + 4 * l4 + i; const float at = acum[t];
                    G[t * TP + s] = (bf16)f2bf(s <= t ? acc[i] * __expf(at - as) * ds : 0.f); }
            }
        }
        __syncthreads();
        {
            float sq[4] = {0.f, 0.f, 0.f, 0.f};
#pragma unroll
            for (int jj = 0; jj < 2; ++jj) {
                const int pj = pj0 + jj; f32x4 a1 = (f32x4){0.f, 0.f, 0.f, 0.f}, a2 = (f32x4){0.f, 0.f, 0.f, 0.f};
#pragma unroll
                for (int kk = 0; kk < 2; ++kk) { const bf16x8 af = *(const LAS bf16x8*)(G + (16 * ti + l15) * TP + 32 * kk + 8 * l4), bfr = *(const LAS bf16x8*)(XT + (16 * pj + l15) * TP + 32 * kk + 8 * l4); a1 = MFMA16(af, bfr, a1); }
#pragma unroll
                for (int kk = 0; kk < 4; ++kk) { const bf16x8 af = *(const LAS bf16x8*)(Cq + (16 * ti + l15) * QP + 32 * kk + 8 * l4), bfr = *(const LAS bf16x8*)(Hb + (16 * pj + l15) * QP + 32 * kk + 8 * l4); a2 = MFMA16(af, bfr, a2); }
                const v2u xw = *(const LAS v2u*)(XT + (16 * pj + l15) * TP + 16 * ti + 4 * l4);
                float xs[4]; xs[0] = __uint_as_float(xw.x << 16); xs[1] = __uint_as_float(xw.x & 0xffff0000u); xs[2] = __uint_as_float(xw.y << 16); xs[3] = __uint_as_float(xw.y & 0xffff0000u);
#pragma unroll
                for (int i = 0; i < 4; ++i) { const int t = 16 * ti + 4 * l4 + i; const float y = a1[i] + __expf(acum[t]) * a2[i] + Dsk * xs[i];
                    const float yg = y * silu(bf2f(zr[jj][i])); sq[i] += yg * yg;
                    O[(size_t)(m0 + t) * D + 512 + hd * 64 + 16 * pj + l15] = (bf16)f2bf(yg); }
            }
#pragma unroll
            for (int i = 0; i < 4; ++i) { float s = sq[i]; s += __shfl_xor(s, 1); s += __shfl_xor(s, 2); s += __shfl_xor(s, 4); s += __shfl_xor(s, 8); sq[i] = s; }
            if (l15 == 0) {
#pragma unroll
                for (int i = 0; i < 4; ++i) SS[(size_t)(m0 + 16 * ti + 4 * l4 + i) * 16 + hd * 2 + (w & 1)] = sq[i];
            }
        }
        {
            const float cd = __expf(acum[63]);
#pragma unroll
            for (int pj = 0; pj < 4; ++pj) {
                Hs[pj] = Hs[pj] * cd;
#pragma unroll
                for (int kk = 0; kk < 2; ++kk) { const bf16x8 af = *(const LAS bf16x8*)(BT + (16 * w + l15) * TP + 32 * kk + 8 * l4), bfr = *(const LAS bf16x8*)(XS + (16 * pj + l15) * TP + 32 * kk + 8 * l4); Hs[pj] = MFMA16(af, bfr, Hs[pj]); }
            }
            __syncthreads();
#pragma unroll
            for (int pj = 0; pj < 4; ++pj) { v2u pk; pk.x = pk2(Hs[pj][0], Hs[pj][1]); pk.y = pk2(Hs[pj][2], Hs[pj][3]); *(LAS v2u*)(Hb + (16 * pj + l15) * QP + 16 * w + 4 * l4) = pk; }
        }
    }
    __syncthreads();
}

__global__ void __launch_bounds__(NWAVES * 64, 2) fwd_kernel(Args args) {
    extern __shared__ __attribute__((aligned(16))) unsigned char lds_raw[];
    LAS unsigned char* lds = (LAS unsigned char*)lds_raw;
    cg::grid_group grid = cg::this_grid();
    const int tid = threadIdx.x, lane = tid & 63, wave = __builtin_amdgcn_readfirstlane(tid >> 6);
    const int G = gridDim.x, gw = blockIdx.x * NWAVES + wave, NGW = G * NWAVES;
    unsigned char* ws = args.ws;
    bf16* XB = (bf16*)(ws + WS_XB); bf16* PB = (bf16*)(ws + WS_PB); bf16* BIG = (bf16*)(ws + WS_BIG);
    float* X = args.out;
    const int lo = args.ph_lo, hi = args.ph_hi;
#define IN(k) (lo <= (k) && (k) < hi)
#define SEAM(k) do { if (IN(k) && IN((k) + 1)) grid.sync(); } while (0)
    if (IN(0)) { prologue(args, lds, gw, NGW, wave, lane); __syncthreads(); }
    SEAM(0);
    if (IN(1)) { pg8::Gemm g{XB, (const bf16*)(ws + WS_W1IN), M, FF2, D}; pg8::StaticOrder S; S.init(M, FF2, G, (int)blockIdx.x);
        pg8::EpiSwiGLU E{BIG, FF}; pg8::gemm_phase<pg8::EpiSwiGLU, pg8::StaticOrder, true, true>(lds, g, S, E); }
    SEAM(1);
    if (IN(2)) { pg8::Gemm g{BIG, (const bf16*)(ws + WS_W1OUT), M, D, FF}; pg8::StaticOrder S; S.init(M, D, G, (int)blockIdx.x);
        pg8::EpiResid<false> E{args.in[0], X, nullptr, ALPHA, 0.5f}; pg8::gemm_phase<pg8::EpiResid<false>, pg8::StaticOrder, true, true>(lds, g, S, E); }
    SEAM(2);
    if (IN(3)) ln_pass(X, args.in[4], args.in[5], XB, gw, NGW, lane);
    SEAM(3);
    if (IN(4)) { pg8::Gemm g{XB, (const bf16*)(ws + WS_WMIX), M, MIXP, D}; pg8::StaticOrder S; S.init(M, MIXP, G, (int)blockIdx.x);
        pg8::EpiBf16<0> E{BIG, MIXP, nullptr, 0, 0, 1.f}; pg8::gemm_phase<pg8::EpiBf16<0>, pg8::StaticOrder, true, true>(lds, g, S, E); }
    SEAM(4);
    if (IN(5)) {
        for (int it = blockIdx.x; it < 192; it += G) {
            if (it < 64) hgrn_item(args, lds, it >> 2, it & 3, tid);
            else ssd_item(args, lds, (it - 64) >> 3, (it - 64) & 7, tid);
        }
    }
    SEAM(5);
    if (IN(6)) ssd_norm_pass(XB, (const float*)(ws + WS_SS), args.in[14], gw, NGW, lane);
    SEAM(6);
    if (IN(7)) { pg8::Gemm g{XB, (const bf16*)(ws + WS_WOUT), M, D, D}; pg8::StaticOrder S; S.init(M, D, G, (int)blockIdx.x);
        pg8::EpiResid<false> E{X, X, nullptr, ALPHA, 1.0f}; pg8::gemm_phase<pg8::EpiResid<false>, pg8::StaticOrder, true, true>(lds, g, S, E); }
    SEAM(7);
    if (IN(8)) ln_pass(X, args.in[16], args.in[17], XB, gw, NGW, lane);
    SEAM(8);
    if (IN(9)) { pg8::Gemm g{XB, (const bf16*)(ws + WS_W2IN), M, FF2, D}; pg8::StaticOrder S; S.init(M, FF2, G, (int)blockIdx.x);
        pg8::EpiSwiGLU E{BIG, FF}; pg8::gemm_phase<pg8::EpiSwiGLU, pg8::StaticOrder, true, true>(lds, g, S, E); }
    SEAM(9);
    if (IN(10)) { pg8::Gemm g{BIG, (const bf16*)(ws + WS_W2OUT), M, D, FF}; pg8::StaticOrder S; S.init(M, D, G, (int)blockIdx.x);
        pg8::EpiResid<false> E{X, X, nullptr, ALPHA, 0.5f}; pg8::gemm_phase<pg8::EpiResid<false>, pg8::StaticOrder, true, true>(lds, g, S, E); }
    SEAM(10);
    if (IN(11)) ln_pass(X, args.in[20], args.in[21], XB, gw, NGW, lane);
    SEAM(11);
    if (IN(12)) { pg8::Gemm g{PB, (const bf16*)(ws + WS_WPROJ), M, D, PLE}; pg8::StaticOrder S; S.init(M, D, G, (int)blockIdx.x);
        pg8::EpiBf16<0> E{BIG, D, nullptr, 0, 0, 1.f}; pg8::gemm_phase<pg8::EpiBf16<0>, pg8::StaticOrder, true, true>(lds, g, S, E); }
    SEAM(12);
    if (IN(13)) { pg8::Gemm g{XB, (const bf16*)(ws + WS_WGATE), M, D, D}; pg8::StaticOrder S; S.init(M, D, G, (int)blockIdx.x);
        pg8::EpiResid<true> E{X, X, BIG, ALPHA, 1.0f}; pg8::gemm_phase<pg8::EpiResid<true>, pg8::StaticOrder, true, true>(lds, g, S, E); }
    SEAM(13);
    if (IN(14)) ln_pass(X, args.in[24], args.in[25], nullptr, gw, NGW, lane);
#undef IN
#undef SEAM
}

constexpr int NPHASE = 15;
#ifndef MK_PER_PHASE
#define MK_PER_PHASE 0
#endif
extern "C" void kernel_launch(void* const* d_in, const int* in_sizes, int n_in, void* d_out, int out_size, void* d_ws, size_t ws_size, hipStream_t stream) {
    static int grid = 0;
    if (grid == 0) {
        if (n_in != 26 || in_sizes[0] != M * D || out_size != M * D || ws_size < WS_END) { fprintf(stderr, "kernel_launch: unexpected shapes (n_in %d, in0 %d, out %d, ws %zu)\n", n_in, n_in > 0 ? in_sizes[0] : -1, out_size, ws_size); grid = -1; return; }
        int dev = 0, cus = 0, per_cu = 0;
        hipGetDevice(&dev); hipDeviceGetAttribute(&cus, hipDeviceAttributeMultiprocessorCount, dev);
        if (hipFuncSetAttribute((const void*)fwd_kernel, hipFuncAttributeMaxDynamicSharedMemorySize, LDS_BYTES) != hipSuccess) { fprintf(stderr, "kernel_launch: hipFuncSetAttribute failed\n"); grid = -1; return; }
        if (hipOccupancyMaxActiveBlocksPerMultiprocessor(&per_cu, (const void*)fwd_kernel, NWAVES * 64, LDS_BYTES) != hipSuccess || per_cu < 1) { fprintf(stderr, "kernel_launch: occupancy query says %d\n", per_cu); per_cu = 1; }
        (void)hipGetLastError();
        grid = cus * (per_cu > 1 ? 1 : per_cu);
        if (grid <= 0) grid = 256;
    }
    if (grid < 0) return;
    Args a{};
    for (int i = 0; i < 26; ++i) a.in[i] = (const float*)d_in[i];
    a.out = (float*)d_out; a.ws = (unsigned char*)d_ws;
#if MK_PER_PHASE
    for (int ph = 0; ph < NPHASE; ++ph) { a.ph_lo = ph; a.ph_hi = ph + 1; hipLaunchKernelGGL(fwd_kernel, dim3(grid), dim3(NWAVES * 64), LDS_BYTES, stream, a); }
#else
    a.ph_lo = 0; a.ph_hi = NPHASE;
    void* kargs[] = {&a};
    hipError_t e = hipLaunchCooperativeKernel((const void*)fwd_kernel, dim3(grid), dim3(NWAVES * 64), kargs, LDS_BYTES, stream);
    if (e != hipSuccess) fprintf(stderr, "cooperative launch failed: %s (grid %d)\n", hipGetErrorString(e), grid);
#endif
}
```

```cpp
#include <hip/hip_runtime.h>
#include <cstdio>
#include <cstdint>
namespace pg8 {
#define PG8_LAS __attribute__((address_space(3)))
typedef unsigned short bf16_t;
typedef short bf16x8 __attribute__((ext_vector_type(8)));
typedef float f32x4 __attribute__((ext_vector_type(4)));
typedef unsigned u32x4 __attribute__((ext_vector_type(4)));
constexpr int BM = 256, BK = 64, HALF = 128, HTB = HALF * BK * 2  , STAGE_BYTES = 8 * HTB, NXCD = 8, WGM = 8;

__host__ __device__ __forceinline__ int lds_byte(int r, int c) { const int st = (r >> 4) * 2 + (c >> 5), rr = r & 15, cc = c & 31, ob = rr * 64 + cc * 2; return st * 1024 + (ob ^ (((ob >> 9) & 1) << 5)); }
__host__ __device__ __forceinline__ void stage_rc(int b, int& R, int& C) { const int st = b / 1024, sb = b % 1024, swz = sb ^ (((sb >> 9) & 1) << 5); R = (st >> 1) * 16 + swz / 64; C = (st & 1) * 32 + (swz % 64) / 2; }
__host__ __device__ __forceinline__ int perm32(int rho) { const int n = rho >> 4, i = rho & 15; return 8 * (i >> 2) + 4 * n + (i & 3); }

struct Unit { int pm, pn; };
struct Gemm { const bf16_t* A; const bf16_t* Bt; int M, N, K; };

struct StaticOrder {
    int nM, nN, nwg, G, c;
    __host__ __device__ void init(int M, int N, int G_, int c_) { nM = M / BM; nN = N / BM; nwg = nM * nN; G = G_; c = c_; }
    __host__ __device__ bool next(int i, Unit& u) const {
        const long L = (long)i * G + c; if (L >= nwg) return false;
        int wgid = (int)L; { const int q = nwg / NXCD, r = nwg % NXCD, xcd = wgid % NXCD, off = wgid / NXCD; wgid = (xcd < r ? xcd * (q + 1) : r * (q + 1) + (xcd - r) * q) + off; }
        const int nig = WGM * nN, gid = wgid / nig, fm = gid * WGM, gsz = (nM - fm) < WGM ? (nM - fm) : WGM;
        u.pm = fm + ((wgid % nig) % gsz); u.pn = (wgid % nig) / gsz; return true;
    }
    __device__ __forceinline__ void a_ready(const Unit&) const {}
    __device__ __forceinline__ void done(const Unit&) const {}
};

__device__ __forceinline__ unsigned cvt_pk_bf16(float lo, float hi) { unsigned r; asm volatile("v_cvt_pk_bf16_f32 %0, %1, %2" : "=v"(r) : "v"(lo), "v"(hi)); return r; }
typedef float f32x2 __attribute__((ext_vector_type(2)));
__device__ __forceinline__ f32x2 gelu_pk(f32x2 v) {
    const f32x2 av = __builtin_elementwise_abs(v), d = av * 0.2316418882f + 1.0f;
    f32x2 t; t.x = __builtin_amdgcn_rcpf(d.x); t.y = __builtin_amdgcn_rcpf(d.y);
    f32x2 q = t * 0.5307027145f + (-0.7265760135f); q = q * t + 0.7107068705f; q = q * t + (-0.142248368f); q = q * t + 0.127414796f; q = q * t;
    const f32x2 s = (v * v) * (-0.72134752044f);
    f32x2 e; e.x = __builtin_amdgcn_exp2f(s.x); e.y = __builtin_amdgcn_exp2f(s.y);
    const f32x2 m = v * (q * e), r = v - m;
    f32x2 o; o.x = v.x < 0.f ? m.x : r.x; o.y = v.y < 0.f ? m.y : r.y; return o;
}

template <int ACT  > struct EpiBf16 {
    static constexpr bool PERM = true, AFTER_DRAIN = false; static_assert(ACT == 0 || ACT == 1, "EpiBf16: ACT is 0 (none) or 1 (gelu_pk)");
    bf16_t* O; int ldc; const float* bias; int split_cols; size_t split_stride; float scale0;
    __device__ __forceinline__ void operator()(const f32x4 (&acc)[2][2][4][2], const Unit& u, int wr, int wc, int fr, int fq) const {
        const int row0 = u.pm * BM + wr * 64 + fr; int colt = u.pn * BM; bf16_t* base = O;
        float sc = 1.f; if (split_cols) { const int t = colt / split_cols; base += (size_t)t * split_stride; colt -= t * split_cols; if (t == 0) sc = scale0; }
        const int col0 = colt + wc * 32 + 8 * fq, bcol0 = u.pn * BM + wc * 32 + 8 * fq;
        f32x4 bv[2][2];
#pragma unroll
        for (int bj = 0; bj < 2; ++bj)
#pragma unroll
            for (int n = 0; n < 2; ++n) bv[bj][n] = bias ? *(const f32x4*)(bias + bcol0 + bj * HALF + 4 * n) : (f32x4){0.f, 0.f, 0.f, 0.f};
#pragma unroll
        for (int ai = 0; ai < 2; ++ai)
#pragma unroll
            for (int m = 0; m < 4; ++m) { bf16_t* rowp = base + (size_t)(row0 + ai * HALF + m * 16) * ldc + col0;
#pragma unroll
                for (int bj = 0; bj < 2; ++bj) { f32x4 v0 = acc[ai][bj][m][0] + bv[bj][0], v1 = acc[ai][bj][m][1] + bv[bj][1];
                    if (ACT == 1) { f32x2 a = gelu_pk((f32x2){v0[0], v0[1]}), b = gelu_pk((f32x2){v0[2], v0[3]}), c = gelu_pk((f32x2){v1[0], v1[1]}), d = gelu_pk((f32x2){v1[2], v1[3]});
                        v0 = (f32x4){a.x, a.y, b.x, b.y}; v1 = (f32x4){c.x, c.y, d.x, d.y}; }
                    v0 = v0 * sc; v1 = v1 * sc; u32x4 w; w.x = cvt_pk_bf16(v0[0], v0[1]); w.y = cvt_pk_bf16(v0[2], v0[3]); w.z = cvt_pk_bf16(v1[0], v1[1]); w.w = cvt_pk_bf16(v1[2], v1[3]);
                    *(u32x4*)(rowp + bj * HALF) = w; } }
    }
};

struct PanelStats {
    unsigned* xbuf;
    unsigned* cnt;
    unsigned* tmo;
    int ntn; float eps;
    unsigned code;
    __device__ __forceinline__ bool run(const f32x4 (&v)[2][2][4][2], const Unit& u, int wr, int wc, int fr, int fq, PG8_LAS unsigned char* lds, int wid, int lane) const {
        typedef float f32x2v __attribute__((ext_vector_type(2)));
        PG8_LAS f32x2v* P = (PG8_LAS f32x2v*)lds;
        PG8_LAS f32x2v* S = (PG8_LAS f32x2v*)(lds + 8192);
        PG8_LAS unsigned* flag = (PG8_LAS unsigned*)(lds + 8192 + 2048);
#pragma unroll
        for (int ai = 0; ai < 2; ++ai)
#pragma unroll
            for (int m = 0; m < 4; ++m) {
                float s = 0.f;
#pragma unroll
                for (int bj = 0; bj < 2; ++bj)
#pragma unroll
                    for (int n = 0; n < 2; ++n) { const f32x4 x = v[ai][bj][m][n]; s += (x[0] + x[1]) + (x[2] + x[3]); }
                s += __shfl_xor(s, 16); s += __shfl_xor(s, 32);
                const float mw = s * (1.0f / 64.0f); float q = 0.f;
#pragma unroll
                for (int bj = 0; bj < 2; ++bj)
#pragma unroll
                    for (int n = 0; n < 2; ++n) { const f32x4 d = v[ai][bj][m][n] - mw; q += (d[0] * d[0] + d[1] * d[1]) + (d[2] * d[2] + d[3] * d[3]); }
                q += __shfl_xor(q, 16); q += __shfl_xor(q, 32);
                if (fq == 0) P[(ai * HALF + wr * 64 + m * 16 + fr) * 4 + wc] = (f32x2v){mw, q};
            }
        asm volatile("s_waitcnt lgkmcnt(0)" ::: "memory"); __builtin_amdgcn_s_barrier(); asm volatile("" ::: "memory");
#if defined(BROKEN_EXCHANGE_NO_WAIT)
#warning BROKEN CONTROL BUILD: the row-statistics exchange does not wait; results are wrong by design
        if (blockIdx.x >= 64) { const long long t0_ = clock64(); while (clock64() - t0_ < 60000) __builtin_amdgcn_s_sleep(8); }
#endif
        const int row = wid * 32 + (lane & 31);
        if (lane < 32) {
            const f32x2v a = P[row * 4 + 0], b = P[row * 4 + 1], c = P[row * 4 + 2], d = P[row * 4 + 3];
            const float mt = (a.x + b.x + c.x + d.x) * 0.25f;
            const float da = a.x - mt, db = b.x - mt, dc = c.x - mt, dd = d.x - mt;
            const float m2 = (a.y + b.y) + (c.y + d.y) + 64.0f * ((da * da + db * db) + (dc * dc + dd * dd));
            unsigned long long* slot = (unsigned long long*)xbuf + ((size_t)(u.pm * BM + row) * 4 + u.pn);
            __hip_atomic_store(slot, ((unsigned long long)__float_as_uint(m2) << 32) | __float_as_uint(mt), __ATOMIC_RELAXED, __HIP_MEMORY_SCOPE_AGENT);
        }
        asm volatile("s_waitcnt vmcnt(0)" ::: "memory");
        if (lane == 0) __hip_atomic_fetch_add(cnt + 64 * u.pm, 1u, __ATOMIC_RELAXED, __HIP_MEMORY_SCOPE_AGENT);
        if (wid == 0) {
            bool dead = false; const unsigned long long t0 = __builtin_amdgcn_s_memrealtime(); const unsigned want = 8u * (unsigned)ntn;
            for (;;) {
#if defined(BROKEN_EXCHANGE_NO_WAIT)
                break;
#endif
                if ((unsigned)__builtin_amdgcn_readfirstlane(__hip_atomic_load(cnt + 64 * u.pm, __ATOMIC_RELAXED, __HIP_MEMORY_SCOPE_AGENT)) >= want) break;
                if (__builtin_amdgcn_s_memrealtime() - t0 > 2000000ull) {
                    if (lane == 0) { unsigned expect = 0u; __hip_atomic_compare_exchange_strong(tmo + 1, &expect, code | (unsigned)(u.pm & 0xff), __ATOMIC_RELAXED, __ATOMIC_RELAXED, __HIP_MEMORY_SCOPE_AGENT);
                                     __hip_atomic_store(tmo, 1u, __ATOMIC_RELAXED, __HIP_MEMORY_SCOPE_AGENT); }
                    dead = true; break; }
                __builtin_amdgcn_s_sleep(2);
            }
            __builtin_amdgcn_fence(__ATOMIC_ACQUIRE, "agent");
            if (lane == 0) flag[0] = dead ? 1u : 0u;
        }
        asm volatile("s_waitcnt vmcnt(0) lgkmcnt(0)" ::: "memory"); __builtin_amdgcn_s_barrier(); asm volatile("" ::: "memory");
        const bool bad = flag[0] != 0u;
        if (lane < 32) {
            const unsigned long long* slot = (const unsigned long long*)xbuf + (size_t)(u.pm * BM + row) * 4; float mt[4], m2[4]; float ms = 0.f;
#pragma unroll
            for (int t = 0; t < 4; ++t) { if (t < ntn) { const unsigned long long w = __hip_atomic_load(slot + t, __ATOMIC_RELAXED, __HIP_MEMORY_SCOPE_AGENT); mt[t] = __uint_as_float((unsigned)w); m2[t] = __uint_as_float((unsigned)(w >> 32)); } else { mt[t] = 0.f; m2[t] = 0.f; } ms += mt[t]; }
            const float mean = ms / (float)ntn; float q = 0.f;
#pragma unroll
            for (int t = 0; t < 4; ++t) if (t < ntn) { const float dm = mt[t] - mean; q += m2[t] + 256.0f * dm * dm; }
            S[row] = (f32x2v){mean, 1.0f / sqrtf(q / (256.0f * (float)ntn) + eps)};
        }
        asm volatile("s_waitcnt lgkmcnt(0)" ::: "memory"); __builtin_amdgcn_s_barrier(); asm volatile("" ::: "memory");
        return bad;
    }
};
struct EpiLnRes {
    static constexpr bool PERM = false, AFTER_DRAIN = true;
    const float* base; float* out; int ldc; const float* bias; PanelStats st; unsigned poison;
    __device__ __forceinline__ void fused(f32x4 (&acc)[2][2][4][2], const Unit& u, int wr, int wc, int fr, int fq, PG8_LAS unsigned char* lds, int wid, int lane) const {
        typedef float f32x2v __attribute__((ext_vector_type(2)));
        const PG8_LAS f32x2v* S = (const PG8_LAS f32x2v*)(lds + 8192);
        const int col0 = u.pn * BM + wc * 32 + 4 * fq;
#pragma unroll
        for (int bj = 0; bj < 2; ++bj)
#pragma unroll
            for (int n = 0; n < 2; ++n) { const f32x4 bv = bias ? *(const f32x4*)(bias + col0 + bj * HALF + n * 16) : (f32x4){0.f, 0.f, 0.f, 0.f};
#pragma unroll
                for (int ai = 0; ai < 2; ++ai)
#pragma unroll
                    for (int m = 0; m < 4; ++m) acc[ai][bj][m][n] += bv; }
        f32x4 pre[4][2][2];
#pragma unroll
        for (int m = 0; m < 4; ++m) { const size_t off = (size_t)(u.pm * BM + wr * 64 + m * 16 + fr) * ldc + col0;
#pragma unroll
            for (int bj = 0; bj < 2; ++bj)
#pragma unroll
                for (int n = 0; n < 2; ++n) pre[m][bj][n] = *(const f32x4*)(base + off + bj * HALF + n * 16); }
        const bool bad = st.run(acc, u, wr, wc, fr, fq, lds, wid, lane) || poison != 0u;
        const float qnan = __builtin_nanf("");
#pragma unroll
        for (int ai = 0; ai < 2; ++ai)
#pragma unroll
            for (int m = 0; m < 4; ++m) { const int r = ai * HALF + wr * 64 + m * 16 + fr; const f32x2v sr = S[r]; const size_t off = (size_t)(u.pm * BM + r) * ldc + col0;
#pragma unroll
                for (int bj = 0; bj < 2; ++bj)
#pragma unroll
                    for (int n = 0; n < 2; ++n) { const f32x4 bs = ai == 0 ? pre[m][bj][n] : *(const f32x4*)(base + off + bj * HALF + n * 16); f32x4 o = bs + (acc[ai][bj][m][n] - sr.x) * sr.y;
                        if (bad) o = (f32x4){qnan, qnan, qnan, qnan}; *(f32x4*)(out + off + bj * HALF + n * 16) = o; }
                if (m & 1) asm volatile("" ::: "memory"); }
    }
};
struct EpiLnResLn {
    static constexpr bool PERM = false, AFTER_DRAIN = true;
    const float* base; float* out; bf16_t* xn; int ldc; const float* bias; PanelStats st1, st2; unsigned poison;
    __device__ __forceinline__ void fused(f32x4 (&acc)[2][2][4][2], const Unit& u, int wr, int wc, int fr, int fq, PG8_LAS unsigned char* lds, int wid, int lane) const {
        typedef float f32x2v __attribute__((ext_vector_type(2))); typedef unsigned u32x2v __attribute__((ext_vector_type(2)));
        const PG8_LAS f32x2v* S = (const PG8_LAS f32x2v*)(lds + 8192);
        const int col0 = u.pn * BM + wc * 32 + 4 * fq;
#pragma unroll
        for (int bj = 0; bj < 2; ++bj)
#pragma unroll
            for (int n = 0; n < 2; ++n) { const f32x4 bv = bias ? *(const f32x4*)(bias + col0 + bj * HALF + n * 16) : (f32x4){0.f, 0.f, 0.f, 0.f};
#pragma unroll
                for (int ai = 0; ai < 2; ++ai)
#pragma unroll
                    for (int m = 0; m < 4; ++m) acc[ai][bj][m][n] += bv; }
        bool bad = st1.run(acc, u, wr, wc, fr, fq, lds, wid, lane) || poison != 0u;
        const float qnan = __builtin_nanf("");
#pragma unroll
        for (int ai = 0; ai < 2; ++ai)
#pragma unroll
            for (int m = 0; m < 4; ++m) { const int r = ai * HALF + wr * 64 + m * 16 + fr; const f32x2v sr = S[r]; const size_t off = (size_t)(u.pm * BM + r) * ldc + col0;
#pragma unroll
                for (int bj = 0; bj < 2; ++bj)
#pragma unroll
                    for (int n = 0; n < 2; ++n) { const f32x4 bs = *(const f32x4*)(base + off + bj * HALF + n * 16); acc[ai][bj][m][n] = bs + (acc[ai][bj][m][n] - sr.x) * sr.y; }
                asm volatile("" : "+v"(acc[ai][0][m][0]), "+v"(acc[ai][0][m][1]), "+v"(acc[ai][1][m][0]), "+v"(acc[ai][1][m][1]));
                if (m & 1) asm volatile("" ::: "memory"); }
        const bool bad1 = bad;
        bad = st2.run(acc, u, wr, wc, fr, fq, lds, wid, lane) || bad;
#pragma unroll
        for (int ai = 0; ai < 2; ++ai)
#pragma unroll
            for (int m = 0; m < 4; ++m) { const int r = ai * HALF + wr * 64 + m * 16 + fr; const f32x2v sr = S[r]; const size_t off = (size_t)(u.pm * BM + r) * ldc + col0;
#pragma unroll
                for (int bj = 0; bj < 2; ++bj)
#pragma unroll
                    for (int n = 0; n < 2; ++n) { const f32x4 x1 = acc[ai][bj][m][n]; *(f32x4*)(out + off + bj * HALF + n * 16) = bad1 ? (f32x4){qnan, qnan, qnan, qnan} : x1;
                        const f32x4 o = (x1 - sr.x) * sr.y; u32x2v w; w.x = cvt_pk_bf16(o[0], o[1]); w.y = cvt_pk_bf16(o[2], o[3]);
                        if (bad) { w.x = 0x7fc07fc0u; w.y = 0x7fc07fc0u; } *(u32x2v*)(xn + off + bj * HALF + n * 16) = w; }
                asm volatile("" ::: "memory"); }
    }
};

template <class Epi, class Sched, bool ALIGN_EPI = false, bool SP2 = false>
__device__ __forceinline__ void gemm_phase(PG8_LAS unsigned char* lds, const Gemm g, const Sched& S, const Epi& E) {
    const int tid = threadIdx.x, wid = __builtin_amdgcn_readfirstlane(tid >> 6), lane = tid & 63, wr = wid >> 2, wc = wid & 3, fr = lane & 15, fq = lane >> 4;
    const int K = g.K, nt = K / BK;
    unsigned voffA[2], voffB[2];
#pragma unroll
    for (int i = 0; i < 2; ++i) { int R, C; stage_rc(tid * 16 + i * 8192, R, C); const int Rb = Epi::PERM ? ((R & ~31) + perm32(R & 31)) : R;
        voffA[i] = (unsigned)(R * K + C) * 2u; voffB[i] = (unsigned)(Rb * K + C) * 2u; }
    const size_t kstep = (size_t)(BK * 2);
    const size_t hstep = (size_t)HALF * K * 2;
    const size_t tstep = 2 * hstep;
    const unsigned ldsw = (unsigned)wid * 1024u;
    const int aoff = lds_byte(wr * 64 + fr, fq * 8), boff = lds_byte(wc * 32 + fr, fq * 8);
#define PG8_SA(b, h) (((b) * 2 + (h)) * HTB)
#define PG8_SB(b, h) ((4 + (b) * 2 + (h)) * HTB)
#define PG8_STAGE(bufoff, gbase, voff) do { _Pragma("unroll") for (int _i = 0; _i < 2; ++_i) \
        __builtin_amdgcn_global_load_lds((const unsigned*)((const char*)(gbase) + (voff)[_i]), (PG8_LAS unsigned*)(lds + (bufoff) + ldsw + _i * 8192), 16, 0, 0); } while (0)
#define PG8_LDA(dst, b, h) do { _Pragma("unroll") for (int m = 0; m < 4; ++m) _Pragma("unroll") for (int k = 0; k < 2; ++k) dst[m][k] = *(const PG8_LAS bf16x8*)(lds + PG8_SA(b, h) + aoff + m * 2048 + k * 1024); } while (0)
#define PG8_LDB(dst, b, h) do { _Pragma("unroll") for (int n = 0; n < 2; ++n) _Pragma("unroll") for (int k = 0; k < 2; ++k) dst[n][k] = *(const PG8_LAS bf16x8*)(lds + PG8_SB(b, h) + boff + n * 2048 + k * 1024); } while (0)
#define PG8_MMA(ai, bj, At, Bt) do { __builtin_amdgcn_s_setprio(1); _Pragma("unroll") for (int m = 0; m < 4; ++m) _Pragma("unroll") for (int n = 0; n < 2; ++n) _Pragma("unroll") for (int k = 0; k < 2; ++k) \
        acc[ai][bj][m][n] = __builtin_amdgcn_mfma_f32_16x16x32_bf16(Bt[n][k], At[m][k], acc[ai][bj][m][n], 0, 0, 0); __builtin_amdgcn_s_setprio(0); } while (0)
#define PG8_WAIT_V(n) asm volatile("s_waitcnt vmcnt(" #n ")" ::: "memory")
#define PG8_WAIT_L(n) asm volatile("s_waitcnt lgkmcnt(" #n ")" ::: "memory")
#define PG8_BAR __builtin_amdgcn_s_barrier()
#define PG8_SCHED __builtin_amdgcn_sched_barrier(0)
    Unit cur, nxt; int ui = 0;
    if (!S.next(0, cur)) return;
    f32x4 acc[2][2][4][2];
#pragma unroll
    for (int a = 0; a < 2; ++a)
#pragma unroll
        for (int b = 0; b < 2; ++b)
#pragma unroll
            for (int m = 0; m < 4; ++m)
#pragma unroll
                for (int n = 0; n < 2; ++n) acc[a][b][m][n] = (f32x4){0.f, 0.f, 0.f, 0.f};
    bf16x8 At[4][2], B0[2][2], B1[2][2];
    const char* cA = (const char*)g.A + (size_t)cur.pm * tstep; const char* cB = (const char*)g.Bt + (size_t)cur.pn * tstep;
    S.a_ready(cur);
    if constexpr (SP2) {
        PG8_STAGE(PG8_SB(0, 0), cB, voffB); PG8_STAGE(PG8_SB(0, 1), cB + hstep, voffB); PG8_STAGE(PG8_SA(0, 0), cA, voffA); PG8_STAGE(PG8_SA(0, 1), cA + hstep, voffA);
        if (wr == 1) PG8_BAR;
        PG8_WAIT_V(2); PG8_BAR;
        PG8_STAGE(PG8_SB(1, 0), cB + kstep, voffB); PG8_STAGE(PG8_SA(1, 0), cA + kstep, voffA); PG8_STAGE(PG8_SB(1, 1), cB + hstep + kstep, voffB);
        PG8_WAIT_V(6); PG8_BAR;
    } else {
        PG8_STAGE(PG8_SB(0, 0), cB, voffB); PG8_STAGE(PG8_SA(0, 0), cA, voffA); PG8_STAGE(PG8_SB(0, 1), cB + hstep, voffB); PG8_STAGE(PG8_SA(0, 1), cA + hstep, voffA);
        if (wr == 1) PG8_BAR;
        PG8_WAIT_V(4); PG8_BAR;
        PG8_STAGE(PG8_SB(1, 0), cB + kstep, voffB); PG8_STAGE(PG8_SA(1, 0), cA + kstep, voffA); PG8_STAGE(PG8_SB(1, 1), cB + hstep + kstep, voffB);
        PG8_WAIT_V(6); PG8_BAR;
    }
    for (;;) {
        const bool has_next = S.next(ui + 1, nxt);
        const char* nA = has_next ? (const char*)g.A + (size_t)nxt.pm * tstep : cA; const char* nB = has_next ? (const char*)g.Bt + (size_t)nxt.pn * tstep : cB;
        for (int t = 0; t < nt; t += 2) {
            const bool last = (t == nt - 2);
            const char* a1 = cA + (size_t)(t + 1) * kstep;
            const char* a2 = last ? nA : cA + (size_t)(t + 2) * kstep; const char* b2 = last ? nB : cB + (size_t)(t + 2) * kstep;
            const char* a3 = a2 + kstep; const char* b3 = b2 + kstep;
            if (last && has_next) S.a_ready(nxt);
            if constexpr (SP2) {
            PG8_LDB(B0, 0, 0); PG8_LDB(B1, 0, 1); PG8_SCHED; PG8_LDA(At, 0, 0); PG8_STAGE(PG8_SA(1, 1), a1 + hstep, voffA);
            PG8_WAIT_V(8); PG8_WAIT_L(0); PG8_BAR; PG8_MMA(0, 0, At, B0); PG8_MMA(0, 1, At, B1); PG8_BAR; PG8_SCHED;
            PG8_LDA(At, 0, 1); PG8_STAGE(PG8_SB(0, 0), b2, voffB); PG8_STAGE(PG8_SB(0, 1), b2 + hstep, voffB); PG8_STAGE(PG8_SA(0, 0), a2, voffA);
            PG8_WAIT_V(8); PG8_WAIT_L(0); PG8_BAR; PG8_MMA(1, 0, At, B0); PG8_MMA(1, 1, At, B1); PG8_BAR; PG8_SCHED;
            PG8_LDB(B0, 1, 0); PG8_LDB(B1, 1, 1); PG8_SCHED; PG8_LDA(At, 1, 0); PG8_STAGE(PG8_SA(0, 1), a2 + hstep, voffA);
            PG8_WAIT_V(8); PG8_WAIT_L(0); PG8_BAR; PG8_MMA(0, 0, At, B0); PG8_MMA(0, 1, At, B1); PG8_BAR; PG8_SCHED;
            PG8_LDA(At, 1, 1); PG8_STAGE(PG8_SB(1, 0), b3, voffB); PG8_STAGE(PG8_SB(1, 1), b3 + hstep, voffB); PG8_STAGE(PG8_SA(1, 0), a3, voffA);
            PG8_WAIT_V(8); PG8_WAIT_L(0); PG8_BAR; PG8_MMA(1, 0, At, B0); PG8_MMA(1, 1, At, B1); PG8_BAR; PG8_SCHED;
            } else {
            PG8_LDB(B0, 0, 0); PG8_SCHED; PG8_LDA(At, 0, 0); PG8_STAGE(PG8_SA(1, 1), a1 + hstep, voffA);
            PG8_WAIT_L(8); PG8_BAR; PG8_WAIT_L(0); PG8_MMA(0, 0, At, B0); PG8_BAR; PG8_SCHED;
            PG8_LDB(B1, 0, 1); PG8_STAGE(PG8_SB(0, 0), b2, voffB);
            PG8_BAR; PG8_WAIT_L(0); PG8_MMA(0, 1, At, B1); PG8_BAR;
            PG8_LDA(At, 0, 1); PG8_STAGE(PG8_SA(0, 0), a2, voffA);
            PG8_BAR; PG8_WAIT_L(0); PG8_MMA(1, 0, At, B0); PG8_BAR; PG8_SCHED;
            PG8_STAGE(PG8_SB(0, 1), b2 + hstep, voffB);
            PG8_WAIT_V(6); PG8_BAR; PG8_MMA(1, 1, At, B1); PG8_BAR;
            PG8_LDB(B0, 1, 0); PG8_SCHED; PG8_LDA(At, 1, 0); PG8_STAGE(PG8_SA(0, 1), a2 + hstep, voffA);
            PG8_WAIT_L(8); PG8_BAR; PG8_WAIT_L(0); PG8_MMA(0, 0, At, B0); PG8_BAR; PG8_SCHED;
            PG8_LDB(B1, 1, 1); PG8_STAGE(PG8_SB(1, 0), b3, voffB);
            PG8_BAR; PG8_WAIT_L(0); PG8_MMA(0, 1, At, B1); PG8_BAR;
            PG8_LDA(At, 1, 1); PG8_STAGE(PG8_SA(1, 0), a3, voffA);
            PG8_BAR; PG8_WAIT_L(0); PG8_MMA(1, 0, At, B0); PG8_BAR; PG8_SCHED;
            PG8_STAGE(PG8_SB(1, 1), b3 + hstep, voffB);
            PG8_WAIT_V(6); PG8_BAR; PG8_MMA(1, 1, At, B1); PG8_BAR;
            }
        }
        if constexpr (ALIGN_EPI) { if (wr == 0) PG8_BAR; }
        if constexpr (!Epi::AFTER_DRAIN) { E(acc, cur, wr, wc, fr, fq); S.done(cur); }
        if (!has_next) break;
#pragma unroll
        for (int a = 0; a < 2; ++a)
#pragma unroll
            for (int b = 0; b < 2; ++b)
#pragma unroll
                for (int m = 0; m < 4; ++m)
#pragma unroll
                    for (int n = 0; n < 2; ++n) acc[a][b][m][n] = (f32x4){0.f, 0.f, 0.f, 0.f};
        cur = nxt; cA = nA; cB = nB; ++ui;
        if constexpr (ALIGN_EPI) { if (wr == 1) PG8_BAR; }
    }
    PG8_WAIT_V(0);
    if constexpr (!ALIGN_EPI) { if (wr == 0) PG8_BAR; }
    PG8_BAR;
    if constexpr (Epi::AFTER_DRAIN) { E.fused(acc, cur, wr, wc, fr, fq, lds, wid, lane); S.done(cur); }
#undef PG8_SA
#undef PG8_SB
#undef PG8_STAGE
#undef PG8_LDA
#undef PG8_LDB
#undef PG8_MMA
#undef PG8_WAIT_V
#undef PG8_WAIT_L
#undef PG8_BAR
#undef PG8_SCHED
}
}

namespace pg8 {
__device__ __forceinline__ float silu_f(float x) { return x * __builtin_amdgcn_rcpf(1.0f + __expf(-x)); }
__device__ __forceinline__ float sigm_f(float x) { return __builtin_amdgcn_rcpf(1.0f + __expf(-x)); }
__device__ __forceinline__ float bfu2f(unsigned short u) { return __uint_as_float((unsigned)u << 16); }
struct EpiSwiGLU {
    static constexpr bool PERM = true, AFTER_DRAIN = false;
    bf16_t* H; int ldh;
    __device__ __forceinline__ void operator()(const f32x4 (&acc)[2][2][4][2], const Unit& u, int wr, int wc, int fr, int fq) const {
        const int row0 = u.pm * BM + wr * 64 + fr, col0 = u.pn * HALF + wc * 32 + 8 * fq;
#pragma unroll
        for (int ai = 0; ai < 2; ++ai)
#pragma unroll
            for (int m = 0; m < 4; ++m) {
                bf16_t* rowp = H + (size_t)(row0 + ai * HALF + m * 16) * ldh + col0;
                const f32x4 g0 = acc[ai][0][m][0], g1 = acc[ai][0][m][1], u0 = acc[ai][1][m][0], u1 = acc[ai][1][m][1];
                u32x4 w;
                w.x = cvt_pk_bf16(silu_f(g0[0]) * u0[0], silu_f(g0[1]) * u0[1]); w.y = cvt_pk_bf16(silu_f(g0[2]) * u0[2], silu_f(g0[3]) * u0[3]);
                w.z = cvt_pk_bf16(silu_f(g1[0]) * u1[0], silu_f(g1[1]) * u1[1]); w.w = cvt_pk_bf16(silu_f(g1[2]) * u1[2], silu_f(g1[3]) * u1[3]);
                *(u32x4*)rowp = w;
            }
    }
};
template <bool GATE> struct EpiResid {
    static constexpr bool PERM = true, AFTER_DRAIN = false;
    const float* res; float* out; const bf16_t* PP; float alpha, s;
    __device__ __forceinline__ void operator()(const f32x4 (&acc)[2][2][4][2], const Unit& u, int wr, int wc, int fr, int fq) const {
        const int row0 = u.pm * BM + wr * 64 + fr, col0 = u.pn * BM + wc * 32 + 8 * fq;
#pragma unroll
        for (int ai = 0; ai < 2; ++ai)
#pragma unroll
            for (int m = 0; m < 4; ++m) {
                const size_t off = (size_t)(row0 + ai * HALF + m * 16) * 1024 + col0;
#pragma unroll
                for (int bj = 0; bj < 2; ++bj) {
                    const f32x4 r0 = *(const f32x4*)(res + off + bj * HALF), r1 = *(const f32x4*)(res + off + bj * HALF + 4);
                    f32x4 a0 = acc[ai][bj][m][0], a1 = acc[ai][bj][m][1];
                    if (GATE) {
                        const u32x4 pw = *(const u32x4*)(PP + off + bj * HALF);
                        a0[0] = sigm_f(a0[0]) * __uint_as_float(pw.x << 16); a0[1] = sigm_f(a0[1]) * __uint_as_float(pw.x & 0xffff0000u);
                        a0[2] = sigm_f(a0[2]) * __uint_as_float(pw.y << 16); a0[3] = sigm_f(a0[3]) * __uint_as_float(pw.y & 0xffff0000u);
                        a1[0] = sigm_f(a1[0]) * __uint_as_float(pw.z << 16); a1[1] = sigm_f(a1[1]) * __uint_as_float(pw.z & 0xffff0000u);
                        a1[2] = sigm_f(a1[2]) * __uint_as_float(pw.w << 16); a1[3] = sigm_f(a1[3]) * __uint_as_float(pw.w & 0xffff0000u);
                    }
                    *(f32x4*)(out + off + bj * HALF) = r0 * alpha + a0 * s; *(f32x4*)(out + off + bj * HALF + 4) = r1 * alpha + a1 * s;
                }
            }
    }
};
}

#include <hip/hip_cooperative_groups.h>
namespace cg = cooperative_groups;
constexpr int NWAVES = 8;
constexpr int BATCH = 16, SEQ = 2048, D = 1024, FF = 2816, FF2 = 2 * FF, PLE = 256, NC = SEQ / 64;
constexpr int M = BATCH * SEQ;
constexpr int MIXN = 3592, MIXP = 3840;
constexpr int UQ = 0, UF = 512, UV = 1024, UG = 1536, UZ = 2048, UX = 2560, UDT = 3584;
constexpr float ALPHA = 1.189207115002721f, LN_EPS = 1e-5f, RMS_EPS = 1e-6f;
constexpr size_t MiB = 1u << 20;
constexpr size_t WS_CTL = 0, CTL_ZERO_BYTES = 65536; constexpr int CW_BAR = 4096;
constexpr size_t WS_W1IN = 1 * MiB, WS_W1OUT = 12 * MiB, WS_WMIX = 18 * MiB, WS_WOUT = 26 * MiB, WS_W2IN = 28 * MiB, WS_W2OUT = 39 * MiB, WS_WGATE = 45 * MiB, WS_WPROJ = 47 * MiB;
constexpr size_t WS_SS = 48 * MiB, WS_XB = 50 * MiB, WS_PB = 114 * MiB, WS_BIG = 130 * MiB, WS_END = 370 * MiB;
constexpr int LDS_BYTES = 135168;

#define LAS __attribute__((address_space(3)))
typedef unsigned short bf16;
typedef float f32x4 __attribute__((ext_vector_type(4)));
typedef short bf16x8 __attribute__((ext_vector_type(8)));
typedef unsigned v4u __attribute__((ext_vector_type(4)));
typedef unsigned v2u __attribute__((ext_vector_type(2)));
__device__ __forceinline__ unsigned f2bf(float f) { unsigned u = __builtin_bit_cast(unsigned, f); return (u + 0x7fffu + ((u >> 16) & 1u)) >> 16; }
__device__ __forceinline__ unsigned pk2(float lo, float hi) { return f2bf(lo) | (f2bf(hi) << 16); }
__device__ __forceinline__ float bf2f(unsigned short u) { return __uint_as_float((unsigned)u << 16); }
__device__ __forceinline__ float silu(float x) { return x * __builtin_amdgcn_rcpf(1.0f + __expf(-x)); }
__device__ __forceinline__ float wave_sum(float v) {
#pragma unroll
    for (int o = 1; o < 64; o <<= 1) v += __shfl_xor(v, o);
    return v;
}
#define MFMA16(a, b, c) __builtin_amdgcn_mfma_f32_16x16x32_bf16((a), (b), (c), 0, 0, 0)

struct Args { const float* in[26]; float* out; unsigned char* ws; int ph_lo, ph_hi; };

__device__ __forceinline__ void tr_item(const float* W, int K, int N, bf16* WT, int k0, int n0, int drow0, LAS float* scr, int lane) {
    const int nn = n0 + (lane & 31);
#pragma unroll 8
    for (int i = 0; i < 32; ++i) { const int kk = 2 * i + (lane >> 5); scr[kk * 33 + (lane & 31)] = (nn < N) ? W[(size_t)(k0 + kk) * N + nn] : 0.f; }
    asm volatile("s_waitcnt lgkmcnt(0)" ::: "memory");
    const int c = lane & 7;
#pragma unroll
    for (int j = 0; j < 4; ++j) { const int n = (lane >> 3) + 8 * j; const LAS float* s = scr + (8 * c) * 33 + n;
        v4u o; o.x = pk2(s[0 * 33], s[1 * 33]); o.y = pk2(s[2 * 33], s[3 * 33]); o.z = pk2(s[4 * 33], s[5 * 33]); o.w = pk2(s[6 * 33], s[7 * 33]);
        *(v4u*)(WT + (size_t)(drow0 + n) * K + k0 + 8 * c) = o; }
    asm volatile("s_waitcnt lgkmcnt(0)" ::: "memory");
}
__device__ __forceinline__ int swiglu_drow(int n0) { return n0 < FF ? 256 * (n0 / 128) + (n0 % 128) : 256 * ((n0 - FF) / 128) + 128 + ((n0 - FF) % 128); }

__device__ __forceinline__ void prologue(const Args& a, LAS unsigned char* lds, int gw, int NGW, int wave, int lane) {
    LAS float* scr = (LAS float*)(lds + wave * 16384);
    unsigned char* ws = a.ws;
    constexpr int I1 = (D / 64) * (FF2 / 32), I2 = (FF / 64) * (D / 32), I3 = (D / 64) * (MIXP / 32), I4 = (D / 64) * (D / 32), I8 = (PLE / 64) * (D / 32);
    constexpr int NIT = 2 * I1 + 2 * I2 + I3 + 2 * I4 + I8;
    for (int it = gw; it < NIT; it += NGW) {
        int r = it;
        if (r < 2 * I1) { const int which = r / I1; r %= I1; const int nb = r % (FF2 / 32), kb = r / (FF2 / 32);
            tr_item(a.in[which ? 18 : 2], D, FF2, (bf16*)(ws + (which ? WS_W2IN : WS_W1IN)), 64 * kb, 32 * nb, swiglu_drow(32 * nb), scr, lane); continue; }
        r -= 2 * I1;
        if (r < 2 * I2) { const int which = r / I2; r %= I2; const int nb = r % (D / 32), kb = r / (D / 32);
            tr_item(a.in[which ? 19 : 3], FF, D, (bf16*)(ws + (which ? WS_W2OUT : WS_W1OUT)), 64 * kb, 32 * nb, 32 * nb, scr, lane); continue; }
        r -= 2 * I2;
        if (r < I3) { const int nb = r % (MIXP / 32), kb = r / (MIXP / 32);
            tr_item(a.in[6], D, MIXN, (bf16*)(ws + WS_WMIX), 64 * kb, 32 * nb, 32 * nb, scr, lane); continue; }
        r -= I3;
        if (r < 2 * I4) { const int which = r / I4; r %= I4; const int nb = r % (D / 32), kb = r / (D / 32);
            tr_item(a.in[which ? 23 : 15], D, D, (bf16*)(ws + (which ? WS_WGATE : WS_WOUT)), 64 * kb, 32 * nb, 32 * nb, scr, lane); continue; }
        r -= 2 * I4;
        { const int nb = r % (D / 32), kb = r / (D / 32);
            tr_item(a.in[22], PLE, D, (bf16*)(ws + WS_WPROJ), 64 * kb, 32 * nb, 32 * nb, scr, lane); }
    }
    const float* x = a.in[0]; bf16* XB = (bf16*)(ws + WS_XB);
    for (int m = gw; m < M; m += NGW) {
        const f32x4* xr = (const f32x4*)(x + (size_t)m * D) + lane; v2u* o = (v2u*)(XB + (size_t)m * D) + lane;
#pragma unroll
        for (int j = 0; j < 4; ++j) { const f32x4 v = xr[64 * j]; v2u w; w.x = pk2(v.x, v.y); w.y = pk2(v.z, v.w); o[64 * j] = w; }
    }
    const float* p = a.in[1]; bf16* PB = (bf16*)(ws + WS_PB);
    for (int m = gw; m < M; m += NGW) {
        const f32x4 v = *((const f32x4*)(p + (size_t)m * PLE) + lane); v2u w; w.x = pk2(v.x, v.y); w.y = pk2(v.z, v.w); *((v2u*)(PB + (size_t)m * PLE) + lane) = w;
    }
}

__device__ __forceinline__ void ln_pass(float* X, const float* g, const float* b, bf16* XB, int gw, int NGW, int lane) {
    f32x4 gv[4], bv[4];
#pragma unroll
    for (int j = 0; j < 4; ++j) { gv[j] = *((const f32x4*)g + lane + 64 * j); bv[j] = *((const f32x4*)b + lane + 64 * j); }
    for (int m = gw; m < M; m += NGW) {
        f32x4* xr = (f32x4*)(X + (size_t)m * D) + lane;
        f32x4 v[4]; float s = 0.f;
#pragma unroll
        for (int j = 0; j < 4; ++j) { v[j] = xr[64 * j]; s += (v[j].x + v[j].y) + (v[j].z + v[j].w); }
        const float mean = wave_sum(s) * (1.f / D); float s2 = 0.f;
#pragma unroll
        for (int j = 0; j < 4; ++j) { v[j] = v[j] - mean; s2 += (v[j].x * v[j].x + v[j].y * v[j].y) + (v[j].z * v[j].z + v[j].w * v[j].w); }
        const float rstd = 1.f / sqrtf(wave_sum(s2) * (1.f / D) + LN_EPS);
#pragma unroll
        for (int j = 0; j < 4; ++j) { v[j] = v[j] * rstd * gv[j] + bv[j]; xr[64 * j] = v[j]; }
        if (XB) { v2u* o = (v2u*)(XB + (size_t)m * D) + lane;
#pragma unroll
            for (int j = 0; j < 4; ++j) { v2u w; w.x = pk2(v[j].x, v[j].y); w.y = pk2(v[j].z, v[j].w); o[64 * j] = w; } }
    }
}

__device__ __forceinline__ void ssd_norm_pass(bf16* O, const float* SS, const float* ng, int gw, int NGW, int lane) {
    float gv[8];
#pragma unroll
    for (int j = 0; j < 8; ++j) gv[j] = ng[8 * lane + j];
    for (int m = gw; m < M; m += NGW) {
        float s = (lane < 16) ? SS[(size_t)m * 16 + lane] : 0.f;
        s = wave_sum(s);
        const float sc = 1.f / sqrtf(s * (1.f / 512.f) + RMS_EPS);
        v4u* pp = (v4u*)(O + (size_t)m * D + 512) + lane; v4u w = *pp;
        float f[8];
        f[0] = __uint_as_float(w.x << 16); f[1] = __uint_as_float(w.x & 0xffff0000u); f[2] = __uint_as_float(w.y << 16); f[3] = __uint_as_float(w.y & 0xffff0000u);
        f[4] = __uint_as_float(w.z << 16); f[5] = __uint_as_float(w.z & 0xffff0000u); f[6] = __uint_as_float(w.w << 16); f[7] = __uint_as_float(w.w & 0xffff0000u);
#pragma unroll
        for (int j = 0; j < 8; ++j) f[j] = f[j] * sc * gv[j];
        w.x = pk2(f[0], f[1]); w.y = pk2(f[2], f[3]); w.z = pk2(f[4], f[5]); w.w = pk2(f[6], f[7]);
        *pp = w;
    }
}

#define LBAR() do { asm volatile("s_waitcnt lgkmcnt(0)" ::: "memory"); __builtin_amdgcn_s_barrier(); asm volatile("" ::: "memory"); } while (0)
constexpr int QP = 136, TP = 72;
constexpr int H_QT = 0, H_KT = H_QT + 64 * QP * 2, H_KTT = H_KT + 64 * QP * 2, H_VT = H_KTT + 128 * TP * 2, H_P = H_VT + 128 * TP * 2, H_ST = H_P + 64 * TP * 2,
              H_DV = H_ST + 128 * QP * 2, H_TOT = H_DV + 512, H_RMS = H_TOT + 2048, H_END = H_RMS + 512;
static_assert(H_END <= 131072, "hgrn lds");
__device__ __forceinline__ void hgrn_item(const Args& a, LAS unsigned char* lds, int b, int h, int tid) {
    const int lane = tid & 63, w = __builtin_amdgcn_readfirstlane(tid >> 6), l15 = lane & 15, l4 = lane >> 4;
    LAS bf16* Qt = (LAS bf16*)(lds + H_QT); LAS bf16* Kt = (LAS bf16*)(lds + H_KT); LAS bf16* KtT = (LAS bf16*)(lds + H_KTT); LAS bf16* VT = (LAS bf16*)(lds + H_VT);
    LAS bf16* P = (LAS bf16*)(lds + H_P); LAS bf16* ST = (LAS bf16*)(lds + H_ST); LAS float* dvec = (LAS float*)(lds + H_DV); LAS float* tot = (LAS float*)(lds + H_TOT); LAS float* rmsx = (LAS float*)(lds + H_RMS);
    const bf16* U = (const bf16*)(a.ws + WS_BIG); bf16* O = (bf16*)(a.ws + WS_XB);
    const int eq = w >> 1, ek = (w & 1) * 64 + lane;
    float lb; { const float l0 = a.in[7][h * 128 + ek], l1 = a.in[7][512 + h * 128 + ek]; lb = 1.f / (1.f + __expf(l1 - l0)); }
    const float* ngp = a.in[8];
    f32x4 S[8];
#pragma unroll
    for (int j = 0; j < 8; ++j) S[j] = (f32x4){0.f, 0.f, 0.f, 0.f};
    for (int i = tid; i < 128 * QP / 2; i += 512) ((LAS unsigned*)ST)[i] = 0u;
    __syncthreads();
    const int ti = w >> 1, vj0 = 4 * (w & 1);
    unsigned short gr[4][4], qr[16], fr[16], vr[16];
    const unsigned vo_e = (unsigned)ek, vo_d = (unsigned)(4 * l4 * MIXP + l15);
#define H_LOAD_QFV(cc) do { const bf16* Ur_ = U + (size_t)(b * SEQ + 64 * (cc) + 16 * eq) * MIXP + h * 128; \
        _Pragma("unroll") for (int j = 0; j < 16; ++j) { qr[j] = (Ur_ + (size_t)j * MIXP + UQ)[vo_e]; fr[j] = (Ur_ + (size_t)j * MIXP + UF)[vo_e]; vr[j] = (Ur_ + (size_t)j * MIXP + UV)[vo_e]; } } while (0)
#define H_LOAD_G(cc) do { const bf16* Ug_ = U + (size_t)(b * SEQ + 64 * (cc) + 16 * ti) * MIXP + UG + h * 128 + 16 * vj0; \
        _Pragma("unroll") for (int jj = 0; jj < 4; ++jj) _Pragma("unroll") for (int i = 0; i < 4; ++i) gr[jj][i] = (Ug_ + (size_t)i * MIXP + 16 * jj)[vo_d]; } while (0)
    H_LOAD_QFV(0); H_LOAD_G(0);
    __builtin_amdgcn_sched_barrier(0);
    for (int c = 0; c < NC; ++c) {
        const int m0 = b * SEQ + 64 * c;
        {
            float bbl[16], fk[16]; float run = 0.f;
#pragma unroll
            for (int j = 0; j < 16; ++j) { const float f = lb + (1.f - lb) * __builtin_amdgcn_rcpf(1.f + __expf(-bf2f(fr[j]))); fk[j] = 1.f - f; run += __logf(f); bbl[j] = run; }
            tot[eq * 128 + ek] = run;
            LBAR();
            float off = 0.f, blast = 0.f;
#pragma unroll
            for (int q = 0; q < 4; ++q) { const float t = tot[q * 128 + ek]; blast += t; if (q < eq) off += t; }
            unsigned kp[8], vp[8];
#pragma unroll
            for (int j = 0; j < 16; j += 2) {
                const float b0 = bbl[j] + off, b1 = bbl[j + 1] + off;
                const unsigned q0 = f2bf(silu(bf2f(qr[j])) * __expf(b0)), q1 = f2bf(silu(bf2f(qr[j + 1])) * __expf(b1));
                const unsigned k0 = f2bf(fk[j] * __expf(-b0)), k1 = f2bf(fk[j + 1] * __expf(-b1));
                Qt[(16 * eq + j) * QP + ek] = (bf16)q0; Qt[(16 * eq + j + 1) * QP + ek] = (bf16)q1;
                Kt[(16 * eq + j) * QP + ek] = (bf16)k0; Kt[(16 * eq + j + 1) * QP + ek] = (bf16)k1;
                kp[j >> 1] = k0 | (k1 << 16); vp[j >> 1] = (unsigned)vr[j] | ((unsigned)vr[j + 1] << 16);
            }
            *(LAS v4u*)(KtT + ek * TP + 16 * eq) = (v4u){kp[0], kp[1], kp[2], kp[3]}; *(LAS v4u*)(KtT + ek * TP + 16 * eq + 8) = (v4u){kp[4], kp[5], kp[6], kp[7]};
            *(LAS v4u*)(VT + ek * TP + 16 * eq) = (v4u){vp[0], vp[1], vp[2], vp[3]}; *(LAS v4u*)(VT + ek * TP + 16 * eq + 8) = (v4u){vp[4], vp[5], vp[6], vp[7]};
            if (eq == 0) dvec[ek] = __expf(blast);
            __builtin_amdgcn_sched_barrier(0);
            if (c + 1 < NC) H_LOAD_QFV(c + 1);
            __builtin_amdgcn_sched_barrier(0);
        }
        LBAR();
        {
            const int sj0 = 2 * (w & 1);
#pragma unroll
            for (int jj = 0; jj < 2; ++jj) {
                const int sj = sj0 + jj; f32x4 acc = (f32x4){0.f, 0.f, 0.f, 0.f};
                if (sj <= ti) {
#pragma unroll
                    for (int kk = 0; kk < 4; ++kk) { const bf16x8 af = *(const LAS bf16x8*)(Qt + (16 * ti + l15) * QP + 32 * kk + 8 * l4), bfr = *(const LAS bf16x8*)(Kt + (16 * sj + l15) * QP + 32 * kk + 8 * l4); acc = MFMA16(af, bfr, acc); }
                }
#pragma unroll
                for (int i = 0; i < 4; ++i) { const int t = 16 * ti + 4 * l4 + i, s = 16 * sj + l15; P[t * TP + s] = (bf16)f2bf(s <= t ? acc[i] : 0.f); }
            }
        }
        LBAR();
        {
            f32x4 o[4];
#pragma unroll
            for (int jj = 0; jj < 4; ++jj) {
                const int vj = vj0 + jj; f32x4 acc = (f32x4){0.f, 0.f, 0.f, 0.f};
#pragma unroll
                for (int kk = 0; kk < 2; ++kk) { const bf16x8 af = *(const LAS bf16x8*)(P + (16 * ti + l15) * TP + 32 * kk + 8 * l4), bfr = *(const LAS bf16x8*)(VT + (16 * vj + l15) * TP + 32 * kk + 8 * l4); acc = MFMA16(af, bfr, acc); }
#pragma unroll
                for (int kk = 0; kk < 4; ++kk) { const bf16x8 af = *(const LAS bf16x8*)(Qt + (16 * ti + l15) * QP + 32 * kk + 8 * l4), bfr = *(const LAS bf16x8*)(ST + (16 * vj + l15) * QP + 32 * kk + 8 * l4); acc = MFMA16(af, bfr, acc); }
                o[jj] = acc;
            }
            float ss[4];
#pragma unroll
            for (int i = 0; i < 4; ++i) { float s = 0.f;
#pragma unroll
                for (int jj = 0; jj < 4; ++jj) s += o[jj][i] * o[jj][i];
                s += __shfl_xor(s, 1); s += __shfl_xor(s, 2); s += __shfl_xor(s, 4); s += __shfl_xor(s, 8); ss[i] = s; }
            if (l15 == 0) {
#pragma unroll
                for (int i = 0; i < 4; ++i) rmsx[(w & 1) * 64 + 16 * ti + 4 * l4 + i] = ss[i];
            }
            LBAR();
#pragma unroll
            for (int i = 0; i < 4; ++i) { const int t = 16 * ti + 4 * l4 + i; const float tot2 = rmsx[t] + rmsx[64 + t]; const float rstd = 1.f / sqrtf(tot2 * (1.f / 128.f) + RMS_EPS);
#pragma unroll
                for (int jj = 0; jj < 4; ++jj) { const int v = 16 * (vj0 + jj) + l15; const float val = o[jj][i] * rstd * ngp[v] * silu(bf2f(gr[jj][i]));
                    O[(size_t)(m0 + t) * D + h * 128 + v] = (bf16)f2bf(val); } }
            __builtin_amdgcn_sched_barrier(0);
            if (c + 1 < NC) H_LOAD_G(c + 1);
            __builtin_amdgcn_sched_barrier(0);
        }
        {
#pragma unroll
            for (int vj = 0; vj < 8; ++vj) {
#pragma unroll
                for (int kk = 0; kk < 2; ++kk) { const bf16x8 af = *(const LAS bf16x8*)(KtT + (16 * w + l15) * TP + 32 * kk + 8 * l4), bfr = *(const LAS bf16x8*)(VT + (16 * vj + l15) * TP + 32 * kk + 8 * l4); S[vj] = MFMA16(af, bfr, S[vj]); }
            }
            const f32x4 dv = *(const LAS f32x4*)(dvec + 16 * w + 4 * l4);
#pragma unroll
            for (int vj = 0; vj < 8; ++vj) { S[vj] = S[vj] * dv; v2u pk; pk.x = pk2(S[vj][0], S[vj][1]); pk.y = pk2(S[vj][2], S[vj][3]); *(LAS v2u*)(ST + (16 * vj + l15) * QP + 16 * w + 4 * l4) = pk; }
        }
    }
    __syncthreads();
}

constexpr int S_CQ = 0, S_BK = S_CQ + 64 * QP * 2, S_BT = S_BK + 64 * QP * 2, S_XT = S_BT + 128 * TP * 2, S_XS = S_XT + 64 * TP * 2, S_G = S_XS + 64 * TP * 2, S_HB = S_G + 64 * TP * 2,
              S_AC = S_HB + 64 * QP * 2, S_DT = S_AC + 256, S_END = S_DT + 256;
static_assert(S_END <= 131072, "ssd lds");
__device__ __forceinline__ void ssd_item(const Args& a, LAS unsigned char* lds, int b, int hd, int tid) {
    const int lane = tid & 63, w = __builtin_amdgcn_readfirstlane(tid >> 6), l15 = lane & 15, l4 = lane >> 4, g = hd >> 2;
    LAS bf16* Cq = (LAS bf16*)(lds + S_CQ); LAS bf16* Bk = (LAS bf16*)(lds + S_BK); LAS bf16* BT = (LAS bf16*)(lds + S_BT); LAS bf16* XT = (LAS bf16*)(lds + S_XT);
    LAS bf16* XS = (LAS bf16*)(lds + S_XS); LAS bf16* G = (LAS bf16*)(lds + S_G); LAS bf16* Hb = (LAS bf16*)(lds + S_HB); LAS float* acum = (LAS float*)(lds + S_AC); LAS float* dtv = (LAS float*)(lds + S_DT);
    const bf16* U = (const bf16*)(a.ws + WS_BIG); bf16* O = (bf16*)(a.ws + WS_XB); float* SS = (float*)(a.ws + WS_SS);
    const float* cw = a.in[9]; const float* cbias = a.in[10];
    const int half = w >> 2, isC = (w >> 1) & 1, n = (w & 1) * 64 + lane;
    const int cbc = 512 + isC * 256 + g * 128 + n;
    const float w0 = cw[cbc], w1 = cw[1024 + cbc], w2 = cw[2048 + cbc], w3 = cw[3072 + cbc], wb = cbias[cbc];
    const int cx = hd * 64 + lane;
    const float x0w = cw[cx], x1w = cw[1024 + cx], x2w = cw[2048 + cx], x3w = cw[3072 + cx], xb = cbias[cx];
    const float Aneg = -__expf(a.in[12][hd]), dtb = a.in[11][hd], Dsk = a.in[13][hd];
    f32x4 Hs[4];
#pragma unroll
    for (int j = 0; j < 4; ++j) Hs[j] = (f32x4){0.f, 0.f, 0.f, 0.f};
    for (int i = tid; i < 64 * QP / 2; i += 512) ((LAS unsigned*)Hb)[i] = 0u;
    __syncthreads();
    const int ti = w >> 1, pj0 = 2 * (w & 1);
    unsigned short zr[2][4], cr[35], xr[11], dtr;
    const unsigned vo_t = (unsigned)(lane * MIXP), vo_n = (unsigned)n, vo_l = (unsigned)lane, vo_d = (unsigned)(4 * l4 * MIXP + l15);
#define S_LOAD_A(cc) do { const int m0_ = b * SEQ + 64 * (cc); dtr = (U + (size_t)m0_ * MIXP + UDT + hd)[vo_t]; \
        const bf16* Uc_ = U + (size_t)(m0_ + 32 * half) * MIXP + UX + 512 + isC * 256 + g * 128; const bool first_ = ((cc) == 0 && half == 0); \
        _Pragma("unroll") for (int j = 0; j < 35; ++j) cr[j] = (first_ && j < 3) ? (unsigned short)0 : (Uc_ + ((ptrdiff_t)j - 3) * (ptrdiff_t)MIXP)[vo_n]; \
        const bf16* Ux_ = U + (size_t)(m0_ + 8 * w) * MIXP + UX + hd * 64; const bool firstx_ = ((cc) == 0 && w == 0); \
        _Pragma("unroll") for (int j = 0; j < 11; ++j) xr[j] = (firstx_ && j < 3) ? (unsigned short)0 : (Ux_ + ((ptrdiff_t)j - 3) * (ptrdiff_t)MIXP)[vo_l]; } while (0)
#define S_LOAD_Z(cc) do { const bf16* Uz_ = U + (size_t)(b * SEQ + 64 * (cc) + 16 * ti) * MIXP + UZ + hd * 64 + 16 * pj0; \
        _Pragma("unroll") for (int jj = 0; jj < 2; ++jj) _Pragma("unroll") for (int i = 0; i < 4; ++i) zr[jj][i] = (Uz_ + (size_t)i * MIXP + 16 * jj)[vo_d]; } while (0)
    S_LOAD_A(0); S_LOAD_Z(0);
    __builtin_amdgcn_sched_barrier(0);
    for (int c = 0; c < NC; ++c) {
        const int m0 = b * SEQ + 64 * c;
        float dt, ac, wdec;
        {
            const float dr = bf2f(dtr) + dtb;
            dt = dr > 20.f ? dr : __logf(1.f + __expf(dr));
            ac = Aneg * dt;
#pragma unroll
            for (int o = 1; o < 64; o <<= 1) { const float t = __shfl_up(ac, o); if (lane >= o) ac += t; }
            const float aclast = __shfl(ac, 63);
            wdec = dt * __expf(aclast - ac);
            if (w == 0) { acum[lane] = ac; dtv[lane] = dt; }
        }
        {
            const int t0 = 32 * half;
            float xm3 = bf2f(cr[0]), xm2 = bf2f(cr[1]), xm1 = bf2f(cr[2]);
            LAS bf16* dst = isC ? Cq : Bk;
#pragma unroll
            for (int j8 = 0; j8 < 4; ++j8) {
                unsigned pk[4];
#pragma unroll
                for (int j = 0; j < 8; ++j) {
                    const float xc = bf2f(cr[3 + 8 * j8 + j]);
                    const float o = silu(wb + w0 * xm3 + w1 * xm2 + w2 * xm1 + w3 * xc);
                    xm3 = xm2; xm2 = xm1; xm1 = xc;
                    const unsigned ob = f2bf(o);
                    dst[(t0 + 8 * j8 + j) * QP + n] = (bf16)ob;
                    if (j & 1) pk[j >> 1] |= ob << 16; else pk[j >> 1] = ob;
                }
                if (!isC) *(LAS v4u*)(BT + n * TP + t0 + 8 * j8) = (v4u){pk[0], pk[1], pk[2], pk[3]};
            }
        }
        {
            const int t0 = 8 * w;
            float xm3 = bf2f(xr[0]), xm2 = bf2f(xr[1]), xm1 = bf2f(xr[2]);
            unsigned pk[4], ps[4];
#pragma unroll
            for (int j = 0; j < 8; ++j) {
                const float xc = bf2f(xr[3 + j]);
                const float o = silu(xb + x0w * xm3 + x1w * xm2 + x2w * xm1 + x3w * xc);
                xm3 = xm2; xm2 = xm1; xm1 = xc;
                const float wt = __shfl(wdec, t0 + j);
                const unsigned ob = f2bf(o), os = f2bf(o * wt);
                if (j & 1) { pk[j >> 1] |= ob << 16; ps[j >> 1] |= os << 16; } else { pk[j >> 1] = ob; ps[j >> 1] = os; }
            }
            *(LAS v4u*)(XT + lane * TP + t0) = (v4u){pk[0], pk[1], pk[2], pk[3]};
            *(LAS v4u*)(XS + lane * TP + t0) = (v4u){ps[0], ps[1], ps[2], ps[3]};
        }
        __builtin_amdgcn_sched_barrier(0);
        if (c + 1 < NC) S_LOAD_A(c + 1);
        __builtin_amdgcn_sched_barrier(0);
        LBAR();
        {
            const int sj0 = 2 * (w & 1);
#pragma unroll
            for (int jj = 0; jj < 2; ++jj) {
                const int sj = sj0 + jj; f32x4 acc = (f32x4){0.f, 0.f, 0.f, 0.f};
                if (sj <= ti) {
#pragma unroll
                    for (int kk = 0; kk < 4; ++kk) { const bf16x8 af = *(const LAS bf16x8*)(Cq + (16 * ti + l15) * QP + 32 * kk + 8 * l4), bfr = *(const LAS bf16x8*)(Bk + (16 * sj + l15) * QP + 32 * kk + 8 * l4); acc = MFMA16(af, bfr, acc); }
                }
                const int s = 16 * sj + l15; const float as = acum[s], ds = dtv[s];
#pragma unroll
                for (int i = 0; i < 4; ++i) { const int t = 16 * ti + 4 * l4 + i; const float at = acum[t];
                    G[t * TP + s] = (bf16)f2bf(s <= t ? acc[i] * __expf(at - as) * ds : 0.f); }
            }
        }
        LBAR();
        {
            float sq[4] = {0.f, 0.f, 0.f, 0.f};
#pragma unroll
            for (int jj = 0; jj < 2; ++jj) {
                const int pj = pj0 + jj; f32x4 a1 = (f32x4){0.f, 0.f, 0.f, 0.f}, a2 = (f32x4){0.f, 0.f, 0.f, 0.f};
#pragma unroll
                for (int kk = 0; kk < 2; ++kk) { const bf16x8 af = *(const LAS bf16x8*)(G + (16 * ti + l15) * TP + 32 * kk + 8 * l4), bfr = *(const LAS bf16x8*)(XT + (16 * pj + l15) * TP + 32 * kk + 8 * l4); a1 = MFMA16(af, bfr, a1); }
#pragma unroll
                for (int kk = 0; kk < 4; ++kk) { const bf16x8 af = *(const LAS bf16x8*)(Cq + (16 * ti + l15) * QP + 32 * kk + 8 * l4), bfr = *(const LAS bf16x8*)(Hb + (16 * pj + l15) * QP + 32 * kk + 8 * l4); a2 = MFMA16(af, bfr, a2); }
                const v2u xw = *(const LAS v2u*)(XT + (16 * pj + l15) * TP + 16 * ti + 4 * l4);
                float xs[4]; xs[0] = __uint_as_float(xw.x << 16); xs[1] = __uint_as_float(xw.x & 0xffff0000u); xs[2] = __uint_as_float(xw.y << 16); xs[3] = __uint_as_float(xw.y & 0xffff0000u);
#pragma unroll
                for (int i = 0; i < 4; ++i) { const int t = 16 * ti + 4 * l4 + i; const float y = a1[i] + __expf(acum[t]) * a2[i] + Dsk * xs[i];
                    const float yg = y * silu(bf2f(zr[jj][i])); sq[i] += yg * yg;
                    O[(size_t)(m0 + t) * D + 512 + hd * 64 + 16 * pj + l15] = (bf16)f2bf(yg); }
            }
#pragma unroll
            for (int i = 0; i < 4; ++i) { float s = sq[i]; s += __shfl_xor(s, 1); s += __shfl_xor(s, 2); s += __shfl_xor(s, 4); s += __shfl_xor(s, 8); sq[i] = s; }
            if (l15 == 0) {
#pragma unroll
                for (int i = 0; i < 4; ++i) SS[(size_t)(m0 + 16 * ti + 4 * l4 + i) * 16 + hd * 2 + (w & 1)] = sq[i];
            }
            __builtin_amdgcn_sched_barrier(0);
            if (c + 1 < NC) S_LOAD_Z(c + 1);
            __builtin_amdgcn_sched_barrier(0);
        }
        {
            const float cd = __expf(acum[63]);
#pragma unroll
            for (int pj = 0; pj < 4; ++pj) {
                Hs[pj] = Hs[pj] * cd;
#pragma unroll
                for (int kk = 0; kk < 2; ++kk) { const bf16x8 af = *(const LAS bf16x8*)(BT + (16 * w + l15) * TP + 32 * kk + 8 * l4), bfr = *(const LAS bf16x8*)(XS + (16 * pj + l15) * TP + 32 * kk + 8 * l4); Hs[pj] = MFMA16(af, bfr, Hs[pj]); }
            }
            LBAR();
#pragma unroll
            for (int pj = 0; pj < 4; ++pj) { v2u pk; pk.x = pk2(Hs[pj][0], Hs[pj][1]); pk.y = pk2(Hs[pj][2], Hs[pj][3]); *(LAS v2u*)(Hb + (16 * pj + l15) * QP + 16 * w + 4 * l4) = pk; }
        }
    }
    __syncthreads();
}

#define XB_TMO      128
#define XB_XCNT(j)  (256  + 64 * (j))
#define XB_XSUB(j)  (1280 + 64 * (j))
#define XB_XGEN(j)  (2304 + 64 * (j))
#define XB_TOP      3328
#define XB_TOPGEN   3392
#define XCD_BAR_WORDS 3456
#define XB_SPIN_CAP (1u << 18)

__device__ __forceinline__ unsigned xb_ld(unsigned* p)              { return __hip_atomic_load(p, __ATOMIC_RELAXED, __HIP_MEMORY_SCOPE_AGENT); }
__device__ __forceinline__ unsigned xb_add(unsigned* p, unsigned v) { return __hip_atomic_fetch_add(p, v, __ATOMIC_RELAXED, __HIP_MEMORY_SCOPE_AGENT); }
__device__ __forceinline__ unsigned xb_xcc_id() { return (unsigned)__builtin_amdgcn_s_getreg((3 << 11) | 20) & 0xFu; }
#define XB_SPIN(cond, bar) do { unsigned _sp = 0; while (cond) { __builtin_amdgcn_s_sleep(1); \
    if ((++_sp & 255u) == 0u) { if (xb_ld(&(bar)[XB_TMO])) break; if (_sp > XB_SPIN_CAP) { atomicAdd(&(bar)[XB_TMO], 1u); break; } } } } while (0)

struct XcdBarrier {
    unsigned* bar; unsigned x;
    volatile LAS unsigned* st;
};

__device__ __forceinline__ XcdBarrier xcd_barrier_post(unsigned* bar, volatile LAS unsigned* st) {
    XcdBarrier b; b.bar = bar; b.x = xb_xcc_id(); b.st = st;
    if (threadIdx.x == 0) (void)xb_add(&bar[XB_XCNT(b.x)], 1u);
    return b;
}
__device__ __forceinline__ void xcd_barrier_complete(unsigned* bar, unsigned x, unsigned& nloc, unsigned& nx) {
    const unsigned G = gridDim.x * gridDim.y * gridDim.z;
    unsigned sum, cnt, mine, sp = 0u;
    for (;;) {
        sum = 0u; cnt = 0u; mine = 0u;
#pragma unroll
        for (unsigned j = 0; j < 16; ++j) { const unsigned c = xb_ld(&bar[XB_XCNT(j)]); sum += c; cnt += (c > 0u) ? 1u : 0u; mine = (j == x) ? c : mine; }
        if (sum == G) break;
        __builtin_amdgcn_s_sleep(1);
        if ((++sp & 255u) == 0u) { if (xb_ld(&bar[XB_TMO])) break; if (sp > XB_SPIN_CAP) { atomicAdd(&bar[XB_TMO], 1u); break; } }
    }
    nloc = mine > 0u ? mine : 1u; nx = cnt > 0u ? cnt : 1u;
}

__device__ __forceinline__ void xcd_barrier(const XcdBarrier& b) {
    asm volatile("s_waitcnt vmcnt(0)" ::: "memory");
    __syncthreads();
    if (threadIdx.x == 0) {
        unsigned* bar = b.bar;
        __builtin_amdgcn_s_waitcnt(0);
        unsigned nloc = b.st[0], nx = b.st[1];
        if (nloc == 0u) { xcd_barrier_complete(bar, b.x, nloc, nx); b.st[0] = nloc; b.st[1] = nx; }
        const unsigned old = xb_add(&bar[XB_XSUB(b.x)], 1u);
        const unsigned gen = old / nloc;
        if (old + 1u == (gen + 1u) * nloc) {
            __builtin_amdgcn_fence(__ATOMIC_RELEASE, "agent");
            asm volatile("s_waitcnt vmcnt(0)" ::: "memory");
            const unsigned og = xb_add(&bar[XB_TOP], 1u);
            const unsigned tg = og / nx;
            if (og + 1u == (tg + 1u) * nx) xb_add(&bar[XB_TOPGEN], 1u);
            else XB_SPIN(xb_ld(&bar[XB_TOPGEN]) == tg, bar);
            __builtin_amdgcn_fence(__ATOMIC_ACQUIRE, "agent");
            xb_add(&bar[XB_XGEN(b.x)], 1u);
            asm volatile("s_waitcnt vmcnt(0)" ::: "memory");
        } else {
            XB_SPIN(xb_ld(&bar[XB_XGEN(b.x)]) == gen, bar);
            __builtin_amdgcn_fence(__ATOMIC_ACQUIRE, "agent");
            asm volatile("s_waitcnt vmcnt(0)" ::: "memory");
        }
    }
    __syncthreads();
}

__global__ void __launch_bounds__(NWAVES * 64, 2) fwd_kernel(Args args) {
    extern __shared__ __attribute__((aligned(16))) unsigned char lds_raw[];
    LAS unsigned char* lds = (LAS unsigned char*)lds_raw;
    cg::grid_group grid = cg::this_grid();
    const int tid = threadIdx.x, lane = tid & 63, wave = __builtin_amdgcn_readfirstlane(tid >> 6);
    const int G = gridDim.x, gw = blockIdx.x * NWAVES + wave, NGW = G * NWAVES;
    unsigned char* ws = args.ws;
    bf16* XB = (bf16*)(ws + WS_XB); bf16* PB = (bf16*)(ws + WS_PB); bf16* BIG = (bf16*)(ws + WS_BIG);
    float* X = args.out;
    const int lo = args.ph_lo, hi = args.ph_hi;
    volatile LAS unsigned* MISC = (volatile LAS unsigned*)(lds + 131072);
    if (tid < 64) MISC[tid] = 0u;
    __syncthreads();
    XcdBarrier bar = xcd_barrier_post((unsigned*)(ws + WS_CTL) + CW_BAR, MISC + 8);
#define IN(k) (lo <= (k) && (k) < hi)
#define SEAM(k) do { if (IN(k) && IN((k) + 1)) { if ((k) == 0) grid.sync(); else xcd_barrier(bar); } } while (0)
    if (IN(0)) { prologue(args, lds, gw, NGW, wave, lane); __syncthreads(); }
    SEAM(0);
    if (IN(1)) { pg8::Gemm g{XB, (const bf16*)(ws + WS_W1IN), M, FF2, D}; pg8::StaticOrder S; S.init(M, FF2, G, (int)blockIdx.x);
        pg8::EpiSwiGLU E{BIG, FF}; pg8::gemm_phase<pg8::EpiSwiGLU, pg8::StaticOrder, true, true>(lds, g, S, E); }
    SEAM(1);
    if (IN(2)) { pg8::Gemm g{BIG, (const bf16*)(ws + WS_W1OUT), M, D, FF}; pg8::StaticOrder S; S.init(M, D, G, (int)blockIdx.x);
        pg8::EpiResid<false> E{args.in[0], X, nullptr, ALPHA, 0.5f}; pg8::gemm_phase<pg8::EpiResid<false>, pg8::StaticOrder, true, true>(lds, g, S, E); }
    SEAM(2);
    if (IN(3)) ln_pass(X, args.in[4], args.in[5], XB, gw, NGW, lane);
    SEAM(3);
    if (IN(4)) { pg8::Gemm g{XB, (const bf16*)(ws + WS_WMIX), M, MIXP, D}; pg8::StaticOrder S; S.init(M, MIXP, G, (int)blockIdx.x);
        pg8::EpiBf16<0> E{BIG, MIXP, nullptr, 0, 0, 1.f}; pg8::gemm_phase<pg8::EpiBf16<0>, pg8::StaticOrder, true, true>(lds, g, S, E); }
    SEAM(4);
    if (IN(5)) {
        for (int it = blockIdx.x; it < 192; it += G) {
            if (it < 64) hgrn_item(args, lds, it >> 2, it & 3, tid);
            else ssd_item(args, lds, (it - 64) >> 3, (it - 64) & 7, tid);
        }
    }
    SEAM(5);
    if (IN(6)) ssd_norm_pass(XB, (const float*)(ws + WS_SS), args.in[14], gw, NGW, lane);
    SEAM(6);
    if (IN(7)) { pg8::Gemm g{XB, (const bf16*)(ws + WS_WOUT), M, D, D}; pg8::StaticOrder S; S.init(M, D, G, (int)blockIdx.x);
        pg8::EpiResid<false> E{X, X, nullptr, ALPHA, 1.0f}; pg8::gemm_phase<pg8::EpiResid<false>, pg8::StaticOrder, true, true>(lds, g, S, E); }
    SEAM(7);
    if (IN(8)) ln_pass(X, args.in[16], args.in[17], XB, gw, NGW, lane);
    SEAM(8);
    if (IN(9)) { pg8::Gemm g{XB, (const bf16*)(ws + WS_W2IN), M, FF2, D}; pg8::StaticOrder S; S.init(M, FF2, G, (int)blockIdx.x);
        pg8::EpiSwiGLU E{BIG, FF}; pg8::gemm_phase<pg8::EpiSwiGLU, pg8::StaticOrder, true, true>(lds, g, S, E); }
    SEAM(9);
    if (IN(10)) { pg8::Gemm g{BIG, (const bf16*)(ws + WS_W2OUT), M, D, FF}; pg8::StaticOrder S; S.init(M, D, G, (int)blockIdx.x);
        pg8::EpiResid<false> E{X, X, nullptr, ALPHA, 0.5f}; pg8::gemm_phase<pg8::EpiResid<false>, pg8::StaticOrder, true, true>(lds, g, S, E); }
    SEAM(10);
    if (IN(11)) ln_pass(X, args.in[20], args.in[21], XB, gw, NGW, lane);
    SEAM(11);
    if (IN(12)) { pg8::Gemm g{PB, (const bf16*)(ws + WS_WPROJ), M, D, PLE}; pg8::StaticOrder S; S.init(M, D, G, (int)blockIdx.x);
        pg8::EpiBf16<0> E{BIG, D, nullptr, 0, 0, 1.f}; pg8::gemm_phase<pg8::EpiBf16<0>, pg8::StaticOrder, true, true>(lds, g, S, E); }
    SEAM(12);
    if (IN(13)) { pg8::Gemm g{XB, (const bf16*)(ws + WS_WGATE), M, D, D}; pg8::StaticOrder S; S.init(M, D, G, (int)blockIdx.x);
        pg8::EpiResid<true> E{X, X, BIG, ALPHA, 1.0f}; pg8::gemm_phase<pg8::EpiResid<true>, pg8::StaticOrder, true, true>(lds, g, S, E); }
    SEAM(13);
    if (IN(14)) ln_pass(X, args.in[24], args.in[25], nullptr, gw, NGW, lane);
#undef IN
#undef SEAM
}

constexpr int NPHASE = 15;
#ifndef MK_PER_PHASE
#define MK_PER_PHASE 0
#endif
extern "C" void kernel_launch(void* const* d_in, const int* in_sizes, int n_in, void* d_out, int out_size, void* d_ws, size_t ws_size, hipStream_t stream) {
    static int grid = 0;
    if (grid == 0) {
        if (n_in != 26 || in_sizes[0] != M * D || out_size != M * D || ws_size < WS_END) { fprintf(stderr, "kernel_launch: unexpected shapes (n_in %d, in0 %d, out %d, ws %zu)\n", n_in, n_in > 0 ? in_sizes[0] : -1, out_size, ws_size); grid = -1; return; }
        int dev = 0, cus = 0, per_cu = 0;
        hipGetDevice(&dev); hipDeviceGetAttribute(&cus, hipDeviceAttributeMultiprocessorCount, dev);
        if (hipFuncSetAttribute((const void*)fwd_kernel, hipFuncAttributeMaxDynamicSharedMemorySize, LDS_BYTES) != hipSuccess) { fprintf(stderr, "kernel_launch: hipFuncSetAttribute failed\n"); grid = -1; return; }
        if (hipOccupancyMaxActiveBlocksPerMultiprocessor(&per_cu, (const void*)fwd_kernel, NWAVES * 64, LDS_BYTES) != hipSuccess || per_cu < 1) { fprintf(stderr, "kernel_launch: occupancy query says %d\n", per_cu); per_cu = 1; }
        (void)hipGetLastError();
        grid = cus * (per_cu > 1 ? 1 : per_cu);
        if (grid <= 0) grid = 256;
    }
    if (grid < 0) return;
    if (hipMemsetAsync((char*)d_ws + WS_CTL, 0, CTL_ZERO_BYTES, stream) != hipSuccess) { fprintf(stderr, "kernel_launch: memset failed\n"); return; }
    Args a{};
    for (int i = 0; i < 26; ++i) a.in[i] = (const float*)d_in[i];
    a.out = (float*)d_out; a.ws = (unsigned char*)d_ws;
#if MK_PER_PHASE
    for (int ph = 0; ph < NPHASE; ++ph) { a.ph_lo = ph; a.ph_hi = ph + 1; hipLaunchKernelGGL(fwd_kernel, dim3(grid), dim3(NWAVES * 64), LDS_BYTES, stream, a); }
#else
    a.ph_lo = 0; a.ph_hi = NPHASE;
    void* kargs[] = {&a};
    hipError_t e = hipLaunchCooperativeKernel((const void*)fwd_kernel, dim3(grid), dim3(NWAVES * 64), kargs, LDS_BYTES, stream);
    if (e != hipSuccess) fprintf(stderr, "cooperative launch failed: %s (grid %d)\n", hipGetErrorString(e), grid);
#endif
}
```
